# Optimizing an MI355X kernel written in HIP

```python
import math
import jax, jax.numpy as jnp
from jax import lax
import numpy as np

D_MODEL = 1024
BATCH = 8
SEQ = 2048
DEPTH = 2

CTX_LEN = 256
GRID_W = 64
N_EVEN = (DEPTH + 1) // 2
N_ODD = DEPTH // 2
N_MOD = 6
EPS = 1e-6
CHUNK = 128

S5_WIDTH = D_MODEL // 2
S5_GROUP = 16
S5_GROUPS = S5_WIDTH // S5_GROUP
S5_STATE = 64

ML_WIDTH = D_MODEL // 2
ML_HEADS = 4
ML_HEAD_DIM = ML_WIDTH // ML_HEADS
ML_CONV = 5
AB_IN = S5_WIDTH + 2 * ML_WIDTH + 4 * ML_HEADS
AB_OUT = S5_WIDTH + ML_WIDTH

RET_HEADS = 4
RET_QK = D_MODEL
RET_V = 2 * D_MODEL
RET_HK = RET_QK // RET_HEADS
RET_HV = RET_V // RET_HEADS
RET_IN = 2 * RET_QK + 2 * RET_V
ROPE_BASE = 10000.0

FFN_HIDDEN = -(-(8 * D_MODEL) // (3 * 256)) * 256

kernel_name = 'hybrid_s5_mlstm_retention_dit'


def rmsnorm(x, g):
    xf = x.astype(jnp.float32)
    y = xf * lax.rsqrt(jnp.mean(xf * xf, -1, keepdims=True) + EPS)
    return (y * g.astype(jnp.float32)).astype(x.dtype)


def headwise_norm(h, g):
    mu = jnp.mean(h, -1, keepdims=True)
    var = jnp.mean(jnp.square(h - mu), -1, keepdims=True)
    y = (h - mu) * lax.rsqrt(var + EPS)
    bn, ln, hn, dn = h.shape
    return y.reshape(bn, ln, hn * dn) * g.astype(jnp.float32)


def modulate(h, shift, scale):
    return h * (1.0 + scale) + shift


def mod_parts(vec, w, b):
    m = jax.nn.silu(vec) @ w + b
    return m.reshape(m.shape[0], 1, N_MOD, D_MODEL)


def swiglu(h, w1, w3, w2):
    return (jax.nn.silu(h @ w1) * (h @ w3)) @ w2


def dwconv_centred(x, w, b):
    y = lax.conv_general_dilated(x.astype(w.dtype), w[:, None, :], window_strides=(1,), padding='SAME',
                                 dimension_numbers=('NWC', 'WIO', 'NWC'), feature_group_count=x.shape[-1])
    return y + b


def grid_rope(rows):
    row = jnp.repeat(jnp.arange(rows, dtype=jnp.float32), GRID_W)
    col = jnp.tile(jnp.arange(GRID_W, dtype=jnp.float32), rows)
    n_freq = RET_HK // 4
    inv = ROPE_BASE ** (-jnp.arange(n_freq, dtype=jnp.float32) / n_freq)
    ang = jnp.concatenate([row[:, None] * inv, col[:, None] * inv], -1)
    return jnp.cos(ang), jnp.sin(ang)


def apply_rope(t, cos, sin):
    half = t.shape[-1] // 2
    t1, t2 = t[..., :half], t[..., half:]
    cs, sn = cos[None, :, None, :], sin[None, :, None, :]
    return jnp.concatenate([t1 * cs - t2 * sn, t2 * cs + t1 * sn], -1)


def maybe_flip(t, flag, axis):
    return jnp.flip(t, axis) if flag else t


def s5_discretise(a_re, a_im, log_dt):
    a_re = a_re.astype(jnp.float32)
    a_im = a_im.astype(jnp.float32)
    dt = jnp.exp(log_dt.astype(jnp.float32))[:, None]
    mag = jnp.exp(a_re * dt)
    abar_re, abar_im = mag * jnp.cos(a_im * dt), mag * jnp.sin(a_im * dt)
    den = a_re * a_re + a_im * a_im
    nr = abar_re - 1.0
    coef_re = (nr * a_re + abar_im * a_im) / den
    coef_im = (abar_im * a_re - nr * a_im) / den
    return abar_re, abar_im, coef_re, coef_im


def _complex_affine_combine(e1, e2):
    a1r, a1i, b1r, b1i = e1
    a2r, a2i, b2r, b2i = e2
    return (a1r * a2r - a1i * a2i, a1r * a2i + a1i * a2r,
            a2r * b1r - a2i * b1i + b2r, a2r * b1i + a2i * b1r + b2i)


def s5_scan(u, disc, b_re, b_im, h0_re, h0_im):
    abar_re, abar_im, coef_re, coef_im = disc
    bu_re = jnp.einsum('blgc,gpc->blgp', u, b_re)
    bu_im = jnp.einsum('blgc,gpc->blgp', u, b_im)
    x_re = coef_re * bu_re - coef_im * bu_im
    x_im = coef_re * bu_im + coef_im * bu_re
    x_re = x_re.at[:, 0].add(abar_re * h0_re - abar_im * h0_im)
    x_im = x_im.at[:, 0].add(abar_re * h0_im + abar_im * h0_re)
    n_pos = u.shape[1]
    a_seq_re = jnp.broadcast_to(abar_re[None, None], (1, n_pos) + abar_re.shape)
    a_seq_im = jnp.broadcast_to(abar_im[None, None], (1, n_pos) + abar_im.shape)
    _, _, s_re, s_im = lax.associative_scan(_complex_affine_combine, (a_seq_re, a_seq_im, x_re, x_im), axis=1)
    return s_re, s_im


def s5_readout(c_re, c_im, s_re, s_im):
    return jnp.einsum('gcp,blgp->blgc', c_re, s_re) - jnp.einsum('gcp,blgp->blgc', c_im, s_im)


def s5_mixer(u_lat, u_ctx, need_ctx, a_re, a_im, log_dt, b_re, b_im, c_re, c_im, d_skip, glu_w, glu_b):
    f32 = jnp.float32
    bn = u_lat.shape[0]

    def groups(u):
        return u.astype(f32).reshape(u.shape[0], u.shape[1], S5_GROUPS, S5_GROUP)

    ul, uc = groups(u_lat), groups(u_ctx)
    dsk = d_skip.astype(f32).reshape(S5_GROUPS, S5_GROUP)
    y_lat = dsk * ul
    y_ctx = dsk * uc if need_ctx else None
    zero = jnp.zeros((bn, S5_GROUPS, S5_STATE), f32)
    for dr in range(2):
        disc = s5_discretise(a_re[dr], a_im[dr], log_dt[dr])
        br, bi = b_re[dr].astype(f32), b_im[dr].astype(f32)
        cr, ci = c_re[dr].astype(f32), c_im[dr].astype(f32)
        sc_re, sc_im = s5_scan(maybe_flip(uc, dr, 1), disc, br, bi, zero, zero)
        sl_re, sl_im = s5_scan(maybe_flip(ul, dr, 1), disc, br, bi, sc_re[:, -1], sc_im[:, -1])
        y_lat = y_lat + maybe_flip(s5_readout(cr, ci, sl_re, sl_im), dr, 1)
        if need_ctx:
            y_ctx = y_ctx + maybe_flip(s5_readout(cr, ci, sc_re, sc_im), dr, 1)

    def glu(y):
        y = jax.nn.gelu(y.reshape(y.shape[0], y.shape[1], S5_WIDTH))
        return y * jax.nn.sigmoid(y @ glu_w.astype(f32) + glu_b.astype(f32))

    return glu(y_lat), (glu(y_ctx) if need_ctx else None)


def mlstm_scan(q, k, v, ig, fg, state, with_output):
    bn, hn, n_pos, dh = q.shape
    nc = n_pos // CHUNK

    def chunks(t):
        return t.reshape((bn, hn, nc, CHUNK) + t.shape[3:])

    q, k, v, ii = chunks(q), chunks(k), chunks(v), chunks(ig)
    b = jnp.cumsum(jax.nn.log_sigmoid(chunks(fg)), -1)
    g_end = b[..., -1:] - b + ii
    g_max = jnp.max(g_end, -1)
    w_end = jnp.exp(g_end - g_max[..., None])
    c_inc = jnp.einsum('bhns,bhnsv,bhnsk->bhnvk', w_end, v, k)
    n_inc = jnp.einsum('bhns,bhnsk->bhnk', w_end, k)

    def step(carry, xs):
        cm, nv, m = carry
        ci, ni, gm, bl = xs
        m_new = jnp.maximum(bl + m, gm)
        dec = jnp.exp(bl + m - m_new)
        inj = jnp.exp(gm - m_new)
        return (dec[..., None, None] * cm + inj[..., None, None] * ci,
                dec[..., None] * nv + inj[..., None] * ni, m_new), (cm, nv, m)

    xs = (jnp.moveaxis(c_inc, 2, 0), jnp.moveaxis(n_inc, 2, 0), jnp.moveaxis(g_max, 2, 0), jnp.moveaxis(b[..., -1], 2, 0))
    final, (c_in, n_in, m_in) = lax.scan(step, state, xs)
    if not with_output:
        return None, final
    c_in, n_in, m_in = jnp.moveaxis(c_in, 0, 2), jnp.moveaxis(n_in, 0, 2), jnp.moveaxis(m_in, 0, 2)
    causal = jnp.tril(jnp.ones((CHUNK, CHUNK), dtype=bool))
    dmat = jnp.where(causal, b[..., :, None] - b[..., None, :] + ii[..., None, :], -jnp.inf)
    m_t = jnp.maximum(b + m_in[..., None], jnp.max(dmat, -1))
    inter = jnp.exp(b + m_in[..., None] - m_t)
    s = jnp.exp(dmat - m_t[..., None]) * jnp.einsum('bhntk,bhnsk->bhnts', q, k)
    num = jnp.einsum('bhnts,bhnsv->bhntv', s, v) + inter[..., None] * jnp.einsum('bhnvk,bhntk->bhntv', c_in, q)
    den = jnp.sum(s, -1) + inter * jnp.einsum('bhnk,bhntk->bhnt', n_in, q)
    h = num / jnp.maximum(jnp.abs(den), jnp.exp(-m_t))[..., None]
    return h.reshape(bn, hn, n_pos, dh), final


def mlstm_mixer(p_lat, p_ctx, need_ctx, conv_w, conv_b, wq, wk, wv, gate_b, norm_g):
    f32 = jnp.float32

    def prepare(p):
        bn, n_pos, _ = p.shape
        xm = p[..., :ML_WIDTH]
        og = p[..., ML_WIDTH:2 * ML_WIDTH]
        gates = (p[..., 2 * ML_WIDTH:] + gate_b).astype(f32).reshape(bn, n_pos, 4, ML_HEADS)
        gates = jnp.transpose(gates, (2, 0, 3, 1))
        xc = jax.nn.silu(dwconv_centred(xm, conv_w, conv_b))
        xc_h = xc.astype(f32).reshape(bn, n_pos, ML_HEADS, ML_HEAD_DIM)
        xm_h = xm.astype(f32).reshape(bn, n_pos, ML_HEADS, ML_HEAD_DIM)
        q = jnp.einsum('blhd,hde->bhle', xc_h, wq.astype(f32))
        k = jnp.einsum('blhd,hde->bhle', xc_h, wk.astype(f32)) * (ML_HEAD_DIM ** -0.5)
        v = jnp.einsum('blhd,hde->bhle', xm_h, wv.astype(f32))
        return q, k, v, gates, og

    ql, kl, vl, gl, ogl = prepare(p_lat)
    qc, kc, vc, gc, ogc = prepare(p_ctx)
    bn = ql.shape[0]
    zero_state = (jnp.zeros((bn, ML_HEADS, ML_HEAD_DIM, ML_HEAD_DIM), f32),
                  jnp.zeros((bn, ML_HEADS, ML_HEAD_DIM), f32),
                  jnp.zeros((bn, ML_HEADS), f32))
    h_lat, h_ctx = None, None
    for dr in range(2):
        hc, st = mlstm_scan(maybe_flip(qc, dr, 2), maybe_flip(kc, dr, 2), maybe_flip(vc, dr, 2),
                            maybe_flip(gc[2 * dr], dr, 2), maybe_flip(gc[2 * dr + 1], dr, 2), zero_state, need_ctx)
        hl, _ = mlstm_scan(maybe_flip(ql, dr, 2), maybe_flip(kl, dr, 2), maybe_flip(vl, dr, 2),
                           maybe_flip(gl[2 * dr], dr, 2), maybe_flip(gl[2 * dr + 1], dr, 2), st, True)
        hl = maybe_flip(hl, dr, 2)
        h_lat = hl if h_lat is None else h_lat + hl
        if need_ctx:
            hc = maybe_flip(hc, dr, 2)
            h_ctx = hc if h_ctx is None else h_ctx + hc

    def finish(h, og):
        h = jnp.transpose(h, (0, 2, 1, 3))
        return jax.nn.sigmoid(og.astype(f32)) * headwise_norm(h, norm_g)

    return finish(h_lat, ogl), (finish(h_ctx, ogc) if need_ctx else None)


def even_mixer(h_lat, h_ctx, need_ctx, w_in, w_out, s5_params, ml_params):
    p_lat = h_lat @ w_in
    p_ctx = h_ctx @ w_in
    s_lat, s_ctx = s5_mixer(p_lat[..., :S5_WIDTH], p_ctx[..., :S5_WIDTH], need_ctx, *s5_params)
    m_lat, m_ctx = mlstm_mixer(p_lat[..., S5_WIDTH:], p_ctx[..., S5_WIDTH:], need_ctx, *ml_params)
    y_lat = jnp.concatenate([s_lat, m_lat], -1) @ w_out
    y_ctx = (jnp.concatenate([s_ctx, m_ctx], -1) @ w_out) if need_ctx else None
    return y_lat, y_ctx


def retention_scan(q, k, v, log_gamma, state, include_diag, with_output):
    bn, hn, n_pos, dk = q.shape
    nc = n_pos // CHUNK
    q = q.reshape(bn, hn, nc, CHUNK, dk)
    k = k.reshape(bn, hn, nc, CHUNK, dk)
    v = v.reshape(bn, hn, nc, CHUNK, v.shape[-1])
    lg = log_gamma.astype(jnp.float32)[:, None]
    pos = jnp.arange(CHUNK, dtype=jnp.float32)
    w_end = jnp.exp(lg * (CHUNK - 1.0 - pos))
    s_inc = jnp.einsum('hs,bhnsk,bhnsv->bhnkv', w_end, k, v)
    chunk_decay = jnp.exp(lg[:, 0] * CHUNK)[None, :, None, None]

    def step(s_state, inc):
        return chunk_decay * s_state + inc, s_state

    final, s_in = lax.scan(step, state, jnp.moveaxis(s_inc, 2, 0))
    if not with_output:
        return None, final
    s_in = jnp.moveaxis(s_in, 0, 2)
    diff = pos[:, None] - pos[None, :]
    mask = (diff >= 0) if include_diag else (diff > 0)
    decay = jnp.where(mask, jnp.exp(lg[:, :, None] * jnp.maximum(diff, 0.0)), 0.0)
    scores = jnp.einsum('bhntk,bhnsk->bhnts', q, k) * decay[None, :, None]
    inter = jnp.exp(lg * (pos + 1.0))
    out = jnp.einsum('bhnts,bhnsv->bhntv', scores, v) + \
        inter[None, :, None, :, None] * jnp.einsum('bhntk,bhnkv->bhntv', q, s_in)
    return out.reshape(bn, hn, n_pos, -1), final


def retention_mixer(h_lat, h_ctx, need_ctx, rope, w_in, w_out, log_gamma, norm_g):
    f32 = jnp.float32

    def prepare(h, rotate):
        bn, n_pos, _ = h.shape
        p = (h @ w_in).astype(f32)
        q = p[..., :RET_QK].reshape(bn, n_pos, RET_HEADS, RET_HK)
        k = p[..., RET_QK:2 * RET_QK].reshape(bn, n_pos, RET_HEADS, RET_HK)
        v = p[..., 2 * RET_QK:2 * RET_QK + RET_V].reshape(bn, n_pos, RET_HEADS, RET_HV)
        g = p[..., 2 * RET_QK + RET_V:]
        if rotate:
            q, k = apply_rope(q, *rope), apply_rope(k, *rope)
        q = q * (RET_HK ** -0.5)
        return (jnp.transpose(q, (0, 2, 1, 3)), jnp.transpose(k, (0, 2, 1, 3)), jnp.transpose(v, (0, 2, 1, 3)), g)

    ql, kl, vl, gl = prepare(h_lat, True)
    qc, kc, vc, gc = prepare(h_ctx, False)
    bn = ql.shape[0]
    zero = jnp.zeros((bn, RET_HEADS, RET_HK, RET_HV), f32)
    o_lat, o_ctx = None, None
    for dr in range(2):
        oc, st = retention_scan(maybe_flip(qc, dr, 2), maybe_flip(kc, dr, 2), maybe_flip(vc, dr, 2),
                                log_gamma[dr], zero, dr == 0, need_ctx)
        ol, _ = retention_scan(maybe_flip(ql, dr, 2), maybe_flip(kl, dr, 2), maybe_flip(vl, dr, 2),
                               log_gamma[dr], st, dr == 0, True)
        ol = maybe_flip(ol, dr, 2)
        o_lat = ol if o_lat is None else o_lat + ol
        if need_ctx:
            oc = maybe_flip(oc, dr, 2)
            o_ctx = oc if o_ctx is None else o_ctx + oc

    def finish(o, g):
        return (jax.nn.silu(g) * headwise_norm(jnp.transpose(o, (0, 2, 1, 3)), norm_g)) @ w_out

    return finish(o_lat, gl), (finish(o_ctx, gc) if need_ctx else None)


def setup_inputs(seed: int = 0) -> dict:
    key = jax.random.key(seed)
    keys = iter(jax.random.split(key, 48))

    def nrm(shape, scale):
        return scale * jax.random.normal(next(keys), shape, jnp.float32)

    d = D_MODEL
    f_bias = jnp.linspace(3.0, 6.0, ML_HEADS, dtype=jnp.float32)
    i_bias = jnp.zeros((ML_HEADS,), jnp.float32)
    gate_base = jnp.concatenate([i_bias, f_bias, i_bias, f_bias])
    gamma_base = jnp.log(1.0 - 2.0 ** (-5.0 - jnp.arange(RET_HEADS, dtype=jnp.float32)))
    return {
        'x': nrm((BATCH, SEQ, d), 1.0),
        'c': nrm((BATCH, d), 1.0),
        'ctx': nrm((BATCH, CTX_LEN, d), 1.0),
        'c_ctx': nrm((d,), 1.0),
        'ada_w': nrm((DEPTH, d, N_MOD * d), 0.5 * d ** -0.5),
        'ada_b': nrm((DEPTH, N_MOD * d), 0.02),
        'norm1_g': 1.0 + nrm((DEPTH, d), 0.02),
        'norm2_g': 1.0 + nrm((DEPTH, d), 0.02),
        'ab_w_in': nrm((N_EVEN, d, AB_IN), d ** -0.5),
        'ab_w_out': nrm((N_EVEN, AB_OUT, d), AB_OUT ** -0.5),
        's5_a_re': -0.5 + nrm((N_EVEN, 2, S5_GROUPS, S5_STATE), 0.01),
        's5_a_im': math.pi * jnp.arange(S5_STATE, dtype=jnp.float32) + nrm((N_EVEN, 2, S5_GROUPS, S5_STATE), 0.01),
        's5_log_dt': jax.random.uniform(next(keys), (N_EVEN, 2, S5_GROUPS), jnp.float32, math.log(1e-3), math.log(1e-1)),
        's5_b_re': nrm((N_EVEN, 2, S5_GROUPS, S5_STATE, S5_GROUP), (2 * S5_GROUP) ** -0.5),
        's5_b_im': nrm((N_EVEN, 2, S5_GROUPS, S5_STATE, S5_GROUP), (2 * S5_GROUP) ** -0.5),
        's5_c_re': nrm((N_EVEN, 2, S5_GROUPS, S5_GROUP, S5_STATE), (2 * S5_STATE) ** -0.5),
        's5_c_im': nrm((N_EVEN, 2, S5_GROUPS, S5_GROUP, S5_STATE), (2 * S5_STATE) ** -0.5),
        's5_d': nrm((N_EVEN, S5_WIDTH), 1.0),
        's5_glu_w': nrm((N_EVEN, S5_WIDTH, S5_WIDTH), S5_WIDTH ** -0.5),
        's5_glu_b': nrm((N_EVEN, S5_WIDTH), 0.02),
        'ml_conv_w': nrm((N_EVEN, ML_CONV, ML_WIDTH), ML_CONV ** -0.5),
        'ml_conv_b': nrm((N_EVEN, ML_WIDTH), 0.02),
        'ml_wq': nrm((N_EVEN, ML_HEADS, ML_HEAD_DIM, ML_HEAD_DIM), ML_HEAD_DIM ** -0.5),
        'ml_wk': nrm((N_EVEN, ML_HEADS, ML_HEAD_DIM, ML_HEAD_DIM), ML_HEAD_DIM ** -0.5),
        'ml_wv': nrm((N_EVEN, ML_HEADS, ML_HEAD_DIM, ML_HEAD_DIM), ML_HEAD_DIM ** -0.5),
        'ml_gate_b': gate_base + nrm((N_EVEN, 4 * ML_HEADS), 0.1),
        'ml_norm_g': 1.0 + nrm((N_EVEN, ML_WIDTH), 0.02),
        'ret_w_in': nrm((N_ODD, d, RET_IN), d ** -0.5),
        'ret_w_out': nrm((N_ODD, RET_V, d), RET_V ** -0.5),
        'ret_log_gamma': gamma_base * (1.0 + nrm((N_ODD, 2, RET_HEADS), 0.05)),
        'ret_norm_g': 1.0 + nrm((N_ODD, RET_V), 0.02),
        'ffn_w1': nrm((DEPTH, d, FFN_HIDDEN), d ** -0.5),
        'ffn_w3': nrm((DEPTH, d, FFN_HIDDEN), d ** -0.5),
        'ffn_w2': nrm((DEPTH, FFN_HIDDEN, d), FFN_HIDDEN ** -0.5),
        'final_g': 1.0 + nrm((d,), 0.02),
    }


def reference(x, c, ctx, c_ctx, ada_w, ada_b, norm1_g, norm2_g, ab_w_in, ab_w_out,
              s5_a_re, s5_a_im, s5_log_dt, s5_b_re, s5_b_im, s5_c_re, s5_c_im, s5_d, s5_glu_w, s5_glu_b,
              ml_conv_w, ml_conv_b, ml_wq, ml_wk, ml_wv, ml_gate_b, ml_norm_g,
              ret_w_in, ret_w_out, ret_log_gamma, ret_norm_g, ffn_w1, ffn_w3, ffn_w2, final_g):
    rows = x.shape[1] // GRID_W
    rope = grid_rope(rows)
    for layer in range(DEPTH):
        need_ctx = layer < DEPTH - 1
        j = layer // 2
        ml = mod_parts(c, ada_w[layer], ada_b[layer])
        mc = mod_parts(c_ctx[None, :], ada_w[layer], ada_b[layer])
        h_lat = modulate(rmsnorm(x, norm1_g[layer]), ml[:, :, 0], ml[:, :, 1])
        h_ctx = modulate(rmsnorm(ctx, norm1_g[layer]), mc[:, :, 0], mc[:, :, 1])
        if layer % 2 == 0:
            s5_params = (s5_a_re[j], s5_a_im[j], s5_log_dt[j], s5_b_re[j], s5_b_im[j], s5_c_re[j], s5_c_im[j],
                         s5_d[j], s5_glu_w[j], s5_glu_b[j])
            ml_params = (ml_conv_w[j], ml_conv_b[j], ml_wq[j], ml_wk[j], ml_wv[j], ml_gate_b[j], ml_norm_g[j])
            y_lat, y_ctx = even_mixer(h_lat, h_ctx, need_ctx, ab_w_in[j], ab_w_out[j], s5_params, ml_params)
        else:
            y_lat, y_ctx = retention_mixer(h_lat, h_ctx, need_ctx, rope, ret_w_in[j], ret_w_out[j],
                                           ret_log_gamma[j], ret_norm_g[j])
        x = x + ml[:, :, 2] * y_lat
        x = x + ml[:, :, 5] * swiglu(modulate(rmsnorm(x, norm2_g[layer]), ml[:, :, 3], ml[:, :, 4]),
                                     ffn_w1[layer], ffn_w3[layer], ffn_w2[layer])
        if need_ctx:
            ctx = ctx + mc[:, :, 2] * y_ctx
            ctx = ctx + mc[:, :, 5] * swiglu(modulate(rmsnorm(ctx, norm2_g[layer]), mc[:, :, 3], mc[:, :, 4]),
                                             ffn_w1[layer], ffn_w3[layer], ffn_w2[layer])
    return rmsnorm(x, final_g)
```

```cpp
#include <hip/hip_runtime.h>
#include <hip/hip_cooperative_groups.h>
#include <cstdio>
#include <cstdint>
namespace cg = cooperative_groups;

typedef unsigned short bf16_t;
typedef short bf16x8 __attribute__((ext_vector_type(8)));
typedef float f32x16 __attribute__((ext_vector_type(16)));
typedef short short2v __attribute__((ext_vector_type(2)));

#define NT 18432
#define TB 2304
#define LDT 72
#define SM_B (2 * 128 * LDT)
#define SM_ELEMS (4 * 128 * LDT)

constexpr size_t MiB = 1u << 20;
constexpr size_t OFF_MOD = 0;
constexpr size_t OFF_ROPE = MiB / 2;
constexpr size_t OFF_CTXS = 5 * MiB / 2;
constexpr size_t OFF_W0 = 21 * MiB / 2;
constexpr size_t W0_IN = OFF_W0;
constexpr size_t W0_OUT = W0_IN + 1664 * 1024 * 2;
constexpr size_t W0_GLU = W0_OUT + 1024 * 1024 * 2;
constexpr size_t W0_Q = W0_GLU + 512 * 512 * 2;
constexpr size_t W0_K = W0_Q + 4 * 128 * 128 * 2;
constexpr size_t W0_V = W0_K + 4 * 128 * 128 * 2;
constexpr size_t W0_13 = W0_V + 4 * 128 * 128 * 2;
constexpr size_t W0_2 = W0_13 + 5632 * 1024 * 2;
constexpr size_t OFF_MISC = 67 * MiB / 2;
constexpr size_t OFF_GATES = OFF_MISC;
constexpr size_t OFF_BC = OFF_GATES + (size_t)NT * 16 * 4;
constexpr size_t OFF_AA = OFF_BC + 64 * TB * 4;
constexpr size_t OFF_PM = OFF_AA + 64 * TB * 4;
constexpr size_t OFF_BL = OFF_PM + 64 * TB * 4;
constexpr size_t OFF_AM = OFF_BL + 64 * 18 * 4 + 1024;
constexpr size_t OFF_GS = OFF_AM + 64 * 18 * 4 + 1024;
constexpr size_t OFF_MU = OFF_GS + 64 * TB * 4;
constexpr size_t OFF_MN = OFF_MU + 64 * 18 * 4 + 1024;
constexpr size_t OFF_KTAB = OFF_MISC + 7 * MiB / 2;
constexpr size_t OFF_G2 = 79 * MiB / 2;
constexpr size_t OFF_E = OFF_G2 + 8 * MiB;
constexpr size_t OFF_MM = OFF_E + 8 * MiB;
constexpr size_t OFF_UG = OFF_MM + 16 * MiB;
constexpr size_t OFF_X = OFF_UG + 18 * MiB + MiB / 4;
constexpr size_t OFF_SIN = OFF_X + 18 * MiB;
constexpr size_t OFF_H = 117 * MiB;
constexpr size_t OFF_XM = 153 * MiB;
constexpr size_t OFF_XC = 171 * MiB;
constexpr size_t OFF_HDIR = 153 * MiB;
constexpr size_t OFF_OG = 189 * MiB;
constexpr size_t OFF_GY = 207 * MiB;
constexpr size_t OFF_VT0 = 225 * MiB;
constexpr size_t OFF_SCR0 = 243 * MiB;
constexpr size_t OFF_HID0 = 153 * MiB;
constexpr size_t L1_Q = 21 * MiB / 2;
constexpr size_t L1_K = L1_Q + 32 * MiB;
constexpr size_t L1_KT = L1_K + 32 * MiB;
constexpr size_t L1_VT = L1_KT + 36 * MiB;
constexpr size_t L1_O = L1_VT + 72 * MiB;
constexpr size_t L1_P = L1_O + 64 * MiB;
constexpr size_t L1_SBF = OFF_CTXS;
constexpr size_t L1_H = L1_O;
constexpr size_t L1_WIN = L1_O + 36 * MiB;
constexpr size_t L1_HL = L1_Q;
constexpr size_t L1_WG = L1_Q + 32 * MiB;
constexpr size_t L1_WOUT = L1_WG + 4 * MiB;
constexpr size_t L1_W13 = L1_WOUT + 4 * MiB;
constexpr size_t L1_W2 = L1_W13 + 11 * MiB;
constexpr size_t L1_H2 = 67 * MiB;
constexpr size_t L1_HID = 103 * MiB;

struct Params { const float* in[35]; float* out; unsigned char* ws; };

__shared__ __attribute__((aligned(16))) bf16_t g_sm[SM_ELEMS];
__shared__ float g_sf[1280];

__device__ __forceinline__ unsigned pack2(float a, float b) { unsigned r; asm("v_cvt_pk_bf16_f32 %0, %1, %2" : "=v"(r) : "v"(a), "v"(b)); return r; }
__device__ __forceinline__ bf16_t f2bf(float f) { return (bf16_t)(pack2(f, 0.f) & 0xffffu); }
__device__ __forceinline__ float bf2f(bf16_t h) { return __uint_as_float(((unsigned)h) << 16); }

__device__ __forceinline__ float blo(unsigned u) { return __uint_as_float(u << 16); }
__device__ __forceinline__ float bhi(unsigned u) { return __uint_as_float(u & 0xffff0000u); }
__device__ __forceinline__ float silu_f(float x) { return x * __builtin_amdgcn_rcpf(1.f + __expf(-x)); }
__device__ __forceinline__ float sigmoid_f(float x) { return __builtin_amdgcn_rcpf(1.f + __expf(-x)); }
__device__ __forceinline__ float gelu_tanh(float x) {
  float z = 0.7978845608028654f * (x + 0.044715f * x * x * x);
  float th = 1.f - 2.f * __builtin_amdgcn_rcpf(1.f + __expf(2.f * z));
  return 0.5f * x * (1.f + th);
}
__device__ __forceinline__ float logsigmoid_f(float x) { return fminf(x, 0.f) - log1pf(__expf(-fabsf(x))); }
__device__ __forceinline__ void sincos_r(float x, float& s, float& c) {
  float n = rintf(x * 0.15915494309189535f);
  float r = fmaf(-n, 6.2831854820251465f, x);
  r = fmaf(-n, -1.7484556000744487e-07f, r);
  s = __sinf(r); c = __cosf(r);
}
__device__ __forceinline__ float wave_sum(float v) {
#pragma unroll
  for (int o = 32; o >= 1; o >>= 1) v += __shfl_xor(v, o);
  return v;
}
__device__ __forceinline__ float wave_max(float v) {
#pragma unroll
  for (int o = 32; o >= 1; o >>= 1) v = fmaxf(v, __shfl_xor(v, o));
  return v;
}
__device__ __forceinline__ uint4 scale8(uint4 v, const float* s) {
  uint4 r;
  r.x = pack2(blo(v.x) * s[0], bhi(v.x) * s[1]);
  r.y = pack2(blo(v.y) * s[2], bhi(v.y) * s[3]);
  r.z = pack2(blo(v.z) * s[4], bhi(v.z) * s[5]);
  r.w = pack2(blo(v.w) * s[6], bhi(v.w) * s[7]);
  return r;
}

__device__ __forceinline__ int opaque_tid() { int t = threadIdx.x; asm volatile("" : "+v"(t)); return t; }
__device__ __forceinline__ uint4 scale8r(uint4 v, float s) {
  uint4 r;
  r.x = pack2(blo(v.x) * s, bhi(v.x) * s);
  r.y = pack2(blo(v.y) * s, bhi(v.y) * s);
  r.z = pack2(blo(v.z) * s, bhi(v.z) * s);
  r.w = pack2(blo(v.w) * s, bhi(v.w) * s);
  return r;
}
#define GS_LOAD(K0)                                                          \
  ra0 = *(const uint4*)(ga + (K0));              rb0 = *(const uint4*)(gb + (K0));              \
  ra1 = *(const uint4*)(ga + 32 * lda + (K0));   rb1 = *(const uint4*)(gb + 32 * ldb + (K0));   \
  ra2 = *(const uint4*)(ga + 64 * lda + (K0));   rb2 = *(const uint4*)(gb + 64 * ldb + (K0));   \
  ra3 = *(const uint4*)(ga + 96 * lda + (K0));   rb3 = *(const uint4*)(gb + 96 * ldb + (K0));   \
  if (KMODE == 2) { kg0 = *(const float4*)(kscale + (K0) + lk); kg1 = *(const float4*)(kscale + (K0) + lk + 4); }
#define GS_STORE(DA, DB, K0)                                                 \
  if (KMODE == 2) { float e_[8] = {__expf(kg0.x - kbias), __expf(kg0.y - kbias), __expf(kg0.z - kbias), __expf(kg0.w - kbias), \
                                   __expf(kg1.x - kbias), __expf(kg1.y - kbias), __expf(kg1.z - kbias), __expf(kg1.w - kbias)}; \
    ra0 = scale8(ra0, e_); ra1 = scale8(ra1, e_); ra2 = scale8(ra2, e_); ra3 = scale8(ra3, e_); }                     \
  else if (kscale) { const float* ks_ = kscale + (K0) + lk;                                                          \
    ra0 = scale8(ra0, ks_); ra1 = scale8(ra1, ks_); ra2 = scale8(ra2, ks_); ra3 = scale8(ra3, ks_); } \
  if (rscale) { ra0 = scale8r(ra0, rscale[lr]); ra1 = scale8r(ra1, rscale[lr + 32]); ra2 = scale8r(ra2, rscale[lr + 64]); ra3 = scale8r(ra3, rscale[lr + 96]); } \
  *(uint4*)(DA) = ra0; *(uint4*)((DA) + 32 * LDT) = ra1; *(uint4*)((DA) + 64 * LDT) = ra2; *(uint4*)((DA) + 96 * LDT) = ra3; \
  *(uint4*)(DB) = rb0; *(uint4*)((DB) + 32 * LDT) = rb1; *(uint4*)((DB) + 64 * LDT) = rb2; *(uint4*)((DB) + 96 * LDT) = rb3;
template <int KMODE = 1>
__device__ __forceinline__ void gemm_seg(f32x16 (&acc)[2][2], const bf16_t* __restrict__ A, size_t lda,
                                         const bf16_t* __restrict__ Bt, size_t ldb, int K, const float* kscale,
                                         const float* rscale = nullptr, float kbias = 0.f) {
  const int tid = opaque_tid(), lane = tid & 63, w = tid >> 6, wm = w >> 1, wn = w & 1;
  const int lr = tid >> 3, lk = (tid & 7) * 8;
  const bf16_t* ga = A + (size_t)lr * lda + lk;
  const bf16_t* gb = Bt + (size_t)lr * ldb + lk;
  uint4 ra0, ra1, ra2, ra3, rb0, rb1, rb2, rb3;
  float4 kg0 = make_float4(0.f, 0.f, 0.f, 0.f), kg1 = kg0; (void)kg0; (void)kg1;
  GS_LOAD(0)
  __syncthreads();
  const int nk = K >> 6;
  bf16_t* sA = g_sm;
  bf16_t* sB = g_sm + SM_B;
  const int soff = lr * LDT + lk;
  GS_STORE(sA + soff, sB + soff, 0)
  __syncthreads();
  const int aoff = (wm * 64 + (lane & 31)) * LDT + (lane >> 5) * 8;
  const int boff = (wn * 64 + (lane & 31)) * LDT + (lane >> 5) * 8;
  for (int kt = 0; kt < nk; ++kt) {
    const int buf = kt & 1;
    const bool more = (kt + 1 < nk);
    const int k1 = (kt + 1) << 6;
    if (more) { GS_LOAD(k1) }
    __builtin_amdgcn_sched_barrier(0);
    const bf16_t* pa = sA + buf * (128 * LDT) + aoff;
    const bf16_t* pb = sB + buf * (128 * LDT) + boff;
    __builtin_amdgcn_s_setprio(1);
#pragma unroll
    for (int kk = 0; kk < 4; ++kk) {
      bf16x8 a0 = *(const bf16x8*)(pa + kk * 16);
      bf16x8 a1 = *(const bf16x8*)(pa + 32 * LDT + kk * 16);
      bf16x8 b0 = *(const bf16x8*)(pb + kk * 16);
      bf16x8 b1 = *(const bf16x8*)(pb + 32 * LDT + kk * 16);
      acc[0][0] = __builtin_amdgcn_mfma_f32_32x32x16_bf16(a0, b0, acc[0][0], 0, 0, 0);
      acc[0][1] = __builtin_amdgcn_mfma_f32_32x32x16_bf16(a0, b1, acc[0][1], 0, 0, 0);
      acc[1][0] = __builtin_amdgcn_mfma_f32_32x32x16_bf16(a1, b0, acc[1][0], 0, 0, 0);
      acc[1][1] = __builtin_amdgcn_mfma_f32_32x32x16_bf16(a1, b1, acc[1][1], 0, 0, 0);
    }
    __builtin_amdgcn_s_setprio(0);
    if (more) {
      bf16_t* dA = sA + (buf ^ 1) * (128 * LDT) + soff;
      bf16_t* dB = sB + (buf ^ 1) * (128 * LDT) + soff;
      GS_STORE(dA, dB, k1)
    }
    __syncthreads();
  }
}

#define GP_LOAD(S, K0)                                                          \
  S##a0 = *(const uint4*)(ga + (K0));              S##b0 = *(const uint4*)(gb + (K0));              \
  S##a1 = *(const uint4*)(ga + 32 * lda + (K0));   S##b1 = *(const uint4*)(gb + 32 * ldb + (K0));   \
  S##a2 = *(const uint4*)(ga + 64 * lda + (K0));   S##b2 = *(const uint4*)(gb + 64 * ldb + (K0));   \
  S##a3 = *(const uint4*)(ga + 96 * lda + (K0));   S##b3 = *(const uint4*)(gb + 96 * ldb + (K0));
#define GP_STORE(S, DA, DB, K0)                                              \
  if (kscale) { const float* ks_ = kscale + (K0) + lk; S##a0 = scale8(S##a0, ks_); S##a1 = scale8(S##a1, ks_); S##a2 = scale8(S##a2, ks_); S##a3 = scale8(S##a3, ks_); } \
  if (rscale) { S##a0 = scale8r(S##a0, rscale[lr]); S##a1 = scale8r(S##a1, rscale[lr + 32]); S##a2 = scale8r(S##a2, rscale[lr + 64]); S##a3 = scale8r(S##a3, rscale[lr + 96]); } \
  *(uint4*)(DA) = S##a0; *(uint4*)((DA) + 32 * LDT) = S##a1; *(uint4*)((DA) + 64 * LDT) = S##a2; *(uint4*)((DA) + 96 * LDT) = S##a3; \
  *(uint4*)(DB) = S##b0; *(uint4*)((DB) + 32 * LDT) = S##b1; *(uint4*)((DB) + 64 * LDT) = S##b2; *(uint4*)((DB) + 96 * LDT) = S##b3;
#define GP_COMPUTE(BUF)                                                      \
  { const bf16_t* pa = sA + (BUF) * (128 * LDT) + aoff;                      \
    const bf16_t* pb = sB + (BUF) * (128 * LDT) + boff;                      \
    __builtin_amdgcn_s_setprio(1);                                           \
    _Pragma("unroll") for (int kk = 0; kk < 4; ++kk) {                       \
      bf16x8 a0 = *(const bf16x8*)(pa + kk * 16);                            \
      bf16x8 a1 = *(const bf16x8*)(pa + 32 * LDT + kk * 16);                 \
      bf16x8 b0 = *(const bf16x8*)(pb + kk * 16);                            \
      bf16x8 b1 = *(const bf16x8*)(pb + 32 * LDT + kk * 16);                 \
      acc[0][0] = __builtin_amdgcn_mfma_f32_32x32x16_bf16(a0, b0, acc[0][0], 0, 0, 0); \
      acc[0][1] = __builtin_amdgcn_mfma_f32_32x32x16_bf16(a0, b1, acc[0][1], 0, 0, 0); \
      acc[1][0] = __builtin_amdgcn_mfma_f32_32x32x16_bf16(a1, b0, acc[1][0], 0, 0, 0); \
      acc[1][1] = __builtin_amdgcn_mfma_f32_32x32x16_bf16(a1, b1, acc[1][1], 0, 0, 0); \
    } __builtin_amdgcn_s_setprio(0); }
__device__ __forceinline__ void gemm_pf2(f32x16 (&acc)[2][2], const bf16_t* __restrict__ A, size_t lda,
                                         const bf16_t* __restrict__ Bt, size_t ldb, int K, const float* kscale,
                                         const float* rscale = nullptr) {
  const int tid = opaque_tid(), lane = tid & 63, w = tid >> 6, wm = w >> 1, wn = w & 1;
  const int lr = tid >> 3, lk = (tid & 7) * 8;
  const bf16_t* ga = A + (size_t)lr * lda + lk;
  const bf16_t* gb = Bt + (size_t)lr * ldb + lk;
  uint4 xa0, xa1, xa2, xa3, xb0, xb1, xb2, xb3, ya0, ya1, ya2, ya3, yb0, yb1, yb2, yb3;
  GP_LOAD(x, 0)
  GP_LOAD(y, 64)
  __syncthreads();
  const int nk = K >> 6;
  bf16_t* sA = g_sm;
  bf16_t* sB = g_sm + SM_B;
  const int soff = lr * LDT + lk;
  GP_STORE(x, sA + soff, sB + soff, 0)
  __syncthreads();
  const int aoff = (wm * 64 + (lane & 31)) * LDT + (lane >> 5) * 8;
  const int boff = (wn * 64 + (lane & 31)) * LDT + (lane >> 5) * 8;
  for (int kt = 0; kt < nk; kt += 2) {
    const int k2 = (kt + 2) << 6, k3 = (kt + 3) << 6;
    if (kt + 2 < nk) { GP_LOAD(x, k2) }
    __builtin_amdgcn_sched_barrier(0);
    GP_COMPUTE(0)
    GP_STORE(y, sA + 128 * LDT + soff, sB + 128 * LDT + soff, k2 - 64)
    __syncthreads();
    if (kt + 3 < nk) { GP_LOAD(y, k3) }
    __builtin_amdgcn_sched_barrier(0);
    GP_COMPUTE(1)
    if (kt + 2 < nk) { GP_STORE(x, sA + soff, sB + soff, k2) }
    __syncthreads();
  }
}

#define GM_LDA(J) ma##J = *(const uint4*)(ga + (size_t)(32 * J) * lda + k0n);
#define GM_LDB(J) mb##J = *(const uint4*)(gb + (size_t)(32 * J) * ldb + k0n);
#define GM_LOAD GM_LDA(0) GM_LDA(1) GM_LDA(2) GM_LDA(3) GM_LDA(4) GM_LDA(5) GM_LDA(6) GM_LDA(7) GM_LDB(0) GM_LDB(1) GM_LDB(2) GM_LDB(3)
#define GM_STA(J) *(uint4*)(sA + soff + 32 * J * LDT) = ma##J;
#define GM_STB(J) *(uint4*)(sB + soff + 32 * J * LDT) = mb##J;
#define GM_STORE GM_STA(0) GM_STA(1) GM_STA(2) GM_STA(3) GM_STA(4) GM_STA(5) GM_STA(6) GM_STA(7) GM_STB(0) GM_STB(1) GM_STB(2) GM_STB(3)
__device__ __forceinline__ void gemm_m256(f32x16 (&acc)[4][2], const bf16_t* __restrict__ A, size_t lda,
                                          const bf16_t* __restrict__ Bt, size_t ldb, int K) {
  const int tid = opaque_tid(), lane = tid & 63, w = tid >> 6, wm = w >> 1, wn = w & 1;
  const int lr = tid >> 3, lk = (tid & 7) * 8;
  const bf16_t* ga = A + (size_t)lr * lda + lk;
  const bf16_t* gb = Bt + (size_t)lr * ldb + lk;
  uint4 ma0, ma1, ma2, ma3, ma4, ma5, ma6, ma7, mb0, mb1, mb2, mb3;
  int k0n = 0;
  GM_LOAD
  const int nk = K >> 6;
  bf16_t* sA = g_sm;
  bf16_t* sB = g_sm + 256 * LDT;
  const int soff = lr * LDT + lk;
  const bf16_t* pa = sA + (wm * 128 + (lane & 31)) * LDT + (lane >> 5) * 8;
  const bf16_t* pb = sB + (wn * 64 + (lane & 31)) * LDT + (lane >> 5) * 8;
  for (int kt = 0; kt < nk; ++kt) {
    __syncthreads();
    GM_STORE
    if (kt + 1 < nk) { k0n = (kt + 1) << 6; GM_LOAD }
    __builtin_amdgcn_sched_barrier(0);
    __syncthreads();
    __builtin_amdgcn_s_setprio(1);
#pragma unroll
    for (int kk = 0; kk < 4; ++kk) {
      bf16x8 b0 = *(const bf16x8*)(pb + kk * 16);
      bf16x8 b1 = *(const bf16x8*)(pb + 32 * LDT + kk * 16);
#pragma unroll
      for (int i = 0; i < 4; ++i) {
        bf16x8 a = *(const bf16x8*)(pa + i * 32 * LDT + kk * 16);
        acc[i][0] = __builtin_amdgcn_mfma_f32_32x32x16_bf16(a, b0, acc[i][0], 0, 0, 0);
        acc[i][1] = __builtin_amdgcn_mfma_f32_32x32x16_bf16(a, b1, acc[i][1], 0, 0, 0);
      }
    }
    __builtin_amdgcn_s_setprio(0);
  }
  __syncthreads();
}
#define ACC4_ZERO(acc)                                  \
  _Pragma("unroll") for (int i_ = 0; i_ < 4; ++i_)      \
  _Pragma("unroll") for (int j_ = 0; j_ < 2; ++j_)      \
  _Pragma("unroll") for (int r_ = 0; r_ < 16; ++r_) acc[i_][j_][r_] = 0.f;
#define EPI4_LOOP                                       \
  _Pragma("unroll") for (int i_ = 0; i_ < 4; ++i_)      \
  _Pragma("unroll") for (int j_ = 0; j_ < 2; ++j_)      \
  _Pragma("unroll") for (int r_ = 0; r_ < 16; ++r_)
#define EPI4_ROW (wm * 128 + i_ * 32 + (r_ & 3) + 8 * (r_ >> 2) + 4 * (lane >> 5))

#define ACC_ZERO(acc)                                   \
  _Pragma("unroll") for (int i_ = 0; i_ < 2; ++i_)      \
  _Pragma("unroll") for (int j_ = 0; j_ < 2; ++j_)      \
  _Pragma("unroll") for (int r_ = 0; r_ < 16; ++r_) acc[i_][j_][r_] = 0.f;
#define EPI_LOOP                                        \
  _Pragma("unroll") for (int i_ = 0; i_ < 2; ++i_)      \
  _Pragma("unroll") for (int j_ = 0; j_ < 2; ++j_)      \
  _Pragma("unroll") for (int r_ = 0; r_ < 16; ++r_)
#define EPI_ROW (wm * 64 + i_ * 32 + (r_ & 3) + 8 * (r_ >> 2) + 4 * (lane >> 5))
#define EPI_COL (wn * 64 + j_ * 32 + (lane & 31))
#define WAVE_IDS const int tid = opaque_tid(), lane = tid & 63, w = tid >> 6, wm = w >> 1, wn = w & 1; (void)tid; (void)wm; (void)wn;

__device__ __forceinline__ void convert_w(const float* src, const float* src2, int ldsrc, int K, bf16_t* dst, int ngroups, int mode, int nsrc,
                          int bid, int G) {
  float* sm = (float*)g_sm;
  const int tid = opaque_tid();
  const int ktiles = K / 128, ntiles = ngroups * ktiles;
  for (int t = bid; t < ntiles; t += G) {
    const int gi = t / ktiles, k0 = (t % ktiles) * 128;
    const float* s = src; int scol = gi * 32; float scale = 1.f; int lim = 1 << 30;
    if (mode == 0) { lim = nsrc; }
    else if (mode == 1) { s = (gi & 1) ? src2 : src; scol = (gi >> 1) * 32; }
    else if (mode == 2) {
      const int n = gi * 32;
      if (n < 2048) {
        const int region = n >> 10, rem = n & 1023, head = rem >> 8, g8 = (rem & 255) >> 5, jj = g8 >> 1, half = g8 & 1;
        scol = region * 1024 + head * 256 + half * 128 + jj * 32;
        if (region == 0) scale = 0.0625f;
      }
    } else if (mode == 3) { scale = 0.08838834764831845f; }
    __syncthreads();
#pragma unroll
    for (int j = 0; j < 4; ++j) {
      const int e = tid + 256 * j, kk = e >> 3, c4 = (e & 7) * 4;
      float4 v = make_float4(0.f, 0.f, 0.f, 0.f);
      if (scol + c4 < lim) v = *(const float4*)(s + (size_t)(k0 + kk) * ldsrc + scol + c4);
      float* d = sm + kk * 33 + c4;
      d[0] = v.x * scale; d[1] = v.y * scale; d[2] = v.z * scale; d[3] = v.w * scale;
    }
    __syncthreads();
#pragma unroll
    for (int j = 0; j < 2; ++j) {
      const int e = tid + 256 * j, nn = e >> 4, kc = (e & 15) * 8;
      const float* r = sm + kc * 33 + nn;
      uint4 o;
      o.x = pack2(r[0], r[33]); o.y = pack2(r[66], r[99]); o.z = pack2(r[132], r[165]); o.w = pack2(r[198], r[231]);
      *(uint4*)(dst + (size_t)(gi * 32 + nn) * K + k0 + kc) = o;
    }
  }
}

__device__ __forceinline__ void ada_phase(const Params& p, int bid, int G) {
  float* sm = (float*)g_sm;
  const int tid = opaque_tid();
  float* mod = (float*)(p.ws + OFF_MOD);
  bool loaded = false;
  for (int it = bid; it < 384; it += G) {
    const int layer = it / 192, cb = it % 192;
    if (!loaded) {
      __syncthreads();
      for (int e = tid; e < 9 * 1024; e += 256) {
        const int v = e >> 10, k = e & 1023;
        const float x = v < 8 ? p.in[1][v * 1024 + k] : p.in[3][k];
        sm[e] = silu_f(x);
      }
      __syncthreads();
      loaded = true;
    }
    const int col = tid & 31, ks = tid >> 5;
    const float* wp = p.in[4] + (size_t)layer * 1024 * 6144 + cb * 32 + col + (size_t)ks * 128 * 6144;
    float a[9];
#pragma unroll
    for (int v = 0; v < 9; ++v) a[v] = 0.f;
#pragma unroll 1
    for (int k0 = 0; k0 < 128; k0 += 8) {
      float wv[8];
#pragma unroll
      for (int u = 0; u < 8; ++u) wv[u] = wp[(size_t)(k0 + u) * 6144];
#pragma unroll
      for (int u = 0; u < 8; ++u)
#pragma unroll
        for (int v = 0; v < 9; ++v) a[v] += sm[v * 1024 + ks * 128 + k0 + u] * wv[u];
    }
    float* red = sm + 9 * 1024;
    __syncthreads();
#pragma unroll
    for (int v = 0; v < 9; ++v) red[(ks * 9 + v) * 32 + col] = a[v];
    __syncthreads();
    if (tid < 32) {
      const float bias = p.in[5][layer * 6144 + cb * 32 + col];
#pragma unroll
      for (int v = 0; v < 9; ++v) {
        float sacc = bias;
#pragma unroll
        for (int q = 0; q < 8; ++q) sacc += red[(q * 9 + v) * 32 + col];
        mod[((size_t)layer * 9 + v) * 6144 + cb * 32 + col] = sacc;
      }
    }
    __syncthreads();
  }
}

__device__ __forceinline__ void rope_phase(const Params& p, int gt, int ngt) {
  float* rc = (float*)(p.ws + OFF_ROPE);
  float* rs = rc + 2048 * 128;
  for (int idx = gt; idx < 2048 * 128; idx += ngt) {
    const int pos = idx >> 7, i = idx & 127;
    const int fr = i & 63;
    const float coord = (i < 64) ? (float)(pos >> 6) : (float)(pos & 63);
    const float inv = exp2f(-(float)fr * (13.287712379549449f / 64.f));
    float s, c; sincos_r(coord * inv, s, c);
    rc[idx] = c; rs[idx] = s;
  }
}

__device__ __forceinline__ void s5_apow(const Params& p, int dir, int g, int pp, float e, float& pr, float& pi) {
  const float are = p.in[10][(dir * 32 + g) * 64 + pp], aim = p.in[11][(dir * 32 + g) * 64 + pp];
  const float dt = __expf(p.in[12][dir * 32 + g]);
  const float mag = __expf(e * are * dt);
  float s, c; sincos_r(e * (aim * dt), s, c);
  pr = mag * c; pi = mag * s;
}
__device__ __forceinline__ void s5_coef(const Params& p, int dir, int g, int pp, float& cr, float& ci) {
  const float are = p.in[10][(dir * 32 + g) * 64 + pp], aim = p.in[11][(dir * 32 + g) * 64 + pp];
  float abr, abi; s5_apow(p, dir, g, pp, 1.f, abr, abi);
  const float den = are * are + aim * aim, nr = abr - 1.f;
  cr = (nr * are + abi * aim) / den;
  ci = (abi * are - nr * aim) / den;
}

__device__ __forceinline__ void s5_ktab_phase(const Params& p, int bid, int G) {
  float* ktab = (float*)(p.ws + OFF_KTAB);
  const int tid = opaque_tid();
  float* sm = (float*)g_sm;
  for (int it = bid; it < 256; it += G) {
    const int g = it >> 3, dir = (it >> 2) & 1, dg = it & 3;
    __syncthreads();
    for (int e = tid; e < 1024; e += 256) {
      sm[e] = p.in[15][(size_t)(dir * 32 + g) * 1024 + e];
      sm[1024 + e] = p.in[16][(size_t)(dir * 32 + g) * 1024 + e];
      sm[2048 + e] = p.in[13][(size_t)(dir * 32 + g) * 1024 + e];
      sm[3072 + e] = p.in[14][(size_t)(dir * 32 + g) * 1024 + e];
    }
    float cr = 0.f, ci = 0.f;
    if (tid < 64) s5_coef(p, dir, g, tid, cr, ci);
    for (int dd = 0; dd < 8; ++dd) {
      const int d = dg * 8 + dd;
      __syncthreads();
      if (tid < 64) {
        float pr, pi;
        s5_apow(p, dir, g, tid, (float)d, pr, pi);
        g_sf[tid] = pr * cr - pi * ci;
        g_sf[64 + tid] = pr * ci + pi * cr;
      }
      __syncthreads();
      const int c = tid >> 4, c2 = tid & 15;
      float acc = 0.f;
#pragma unroll 8
      for (int pp = 0; pp < 64; ++pp) {
        const float wr = g_sf[pp], wi = g_sf[64 + pp];
        const float a = sm[c * 64 + pp], b = sm[1024 + c * 64 + pp];
        const float cwr = a * wr - b * wi, cwi = a * wi + b * wr;
        acc += cwr * sm[2048 + pp * 16 + c2] - cwi * sm[3072 + pp * 16 + c2];
      }
      ktab[((size_t)(g * 2 + dir) * 32 + d) * 256 + tid] = acc;
    }
  }
}

__device__ __forceinline__ void s5_build_phase(const Params& p, int gt, int ngt) {
  bf16_t* G2 = (bf16_t*)(p.ws + OFF_G2);
  bf16_t* E = (bf16_t*)(p.ws + OFF_E);
  bf16_t* Mm = (bf16_t*)(p.ws + OFF_MM);
  const float* ktab = (const float*)(p.ws + OFF_KTAB);
  for (int idx = gt; idx < 32 * 256 * 32; idx += ngt) {
    const int j = idx & 31, n2 = (idx >> 5) & 255, g = idx >> 13;
    const int dir = n2 >> 7, ri = (n2 >> 6) & 1, pp = n2 & 63;
    const float e = dir ? (float)j : (float)(31 - j);
    float pr, pi, cr, ci;
    s5_apow(p, dir, g, pp, e, pr, pi);
    s5_coef(p, dir, g, pp, cr, ci);
    const float wr = pr * cr - pi * ci, wi = pr * ci + pi * cr;
    const float* Bre = p.in[13] + ((size_t)(dir * 32 + g) * 64 + pp) * 16;
    const float* Bim = p.in[14] + ((size_t)(dir * 32 + g) * 64 + pp) * 16;
    bf16_t* dst = G2 + ((size_t)g * 256 + n2) * 512 + j * 16;
    float vv[16];
#pragma unroll
    for (int c = 0; c < 16; ++c) vv[c] = ri ? (wr * Bim[c] + wi * Bre[c]) : (wr * Bre[c] - wi * Bim[c]);
    uint4 o0, o1;
    o0.x = pack2(vv[0], vv[1]); o0.y = pack2(vv[2], vv[3]); o0.z = pack2(vv[4], vv[5]); o0.w = pack2(vv[6], vv[7]);
    o1.x = pack2(vv[8], vv[9]); o1.y = pack2(vv[10], vv[11]); o1.z = pack2(vv[12], vv[13]); o1.w = pack2(vv[14], vv[15]);
    *(uint4*)dst = o0; *(uint4*)(dst + 8) = o1;
  }
  for (int idx = gt; idx < 32 * 32 * 2 * 64; idx += ngt) {
    const int pp = idx & 63, dir = (idx >> 6) & 1, t = (idx >> 7) & 31, g = idx >> 12;
    const float f = dir ? (float)(32 - t) : (float)(t + 1);
    float pr, pi; s5_apow(p, dir, g, pp, f, pr, pi);
    const float* Cre = p.in[15] + (size_t)(dir * 32 + g) * 16 * 64 + pp;
    const float* Cim = p.in[16] + (size_t)(dir * 32 + g) * 16 * 64 + pp;
#pragma unroll
    for (int c = 0; c < 16; ++c) {
      const float cr = Cre[c * 64], ci = Cim[c * 64];
      bf16_t* dst = E + ((size_t)g * 512 + t * 16 + c) * 256 + dir * 128 + pp;
      dst[0] = f2bf(cr * pr - ci * pi);
      dst[64] = f2bf(-(cr * pi + ci * pr));
    }
  }
  for (int idx = gt; idx < 32 * 32 * 16 * 32; idx += ngt) {
    const int j = idx & 31, c = (idx >> 5) & 15, t = (idx >> 9) & 31, g = idx >> 14;
    bf16_t* dst = Mm + ((size_t)g * 512 + t * 16 + c) * 512 + j * 16;
    const float* kf = ktab + ((size_t)(g * 2 + 0) * 32 + (t >= j ? t - j : 0)) * 256 + c * 16;
    const float* kb = ktab + ((size_t)(g * 2 + 1) * 32 + (j >= t ? j - t : 0)) * 256 + c * 16;
    const float dsk = p.in[17][g * 16 + c];
    float vv[16];
#pragma unroll
    for (int c2 = 0; c2 < 16; ++c2) {
      float v = 0.f;
      if (j <= t) v += kf[c2];
      if (j >= t) v += kb[c2];
      if (j == t && c2 == c) v += dsk;
      vv[c2] = v;
    }
    uint4 o0, o1;
    o0.x = pack2(vv[0], vv[1]); o0.y = pack2(vv[2], vv[3]); o0.z = pack2(vv[4], vv[5]); o0.w = pack2(vv[6], vv[7]);
    o1.x = pack2(vv[8], vv[9]); o1.y = pack2(vv[10], vv[11]); o1.z = pack2(vv[12], vv[13]); o1.w = pack2(vv[14], vv[15]);
    *(uint4*)dst = o0; *(uint4*)(dst + 8) = o1;
  }
}

__device__ __forceinline__ void rmsnorm_mod_phase(const Params& p, int mode, const float* g, int layer, int shift_idx, bf16_t* h, int gw, int nw) {
  const int lane = threadIdx.x & 63;
  const float* mod = (const float*)(p.ws + OFF_MOD) + (size_t)layer * 9 * 6144;
  const float* ctxs = (const float*)(p.ws + OFF_CTXS);
  const int nrows = mode == 2 ? 16384 : NT;
  for (int r = gw; r < nrows; r += nw) {
    const float* src; int v;
    if (mode == 2) { src = p.out + (size_t)r * 1024; v = r >> 11; }
    else {
      const int b = r / TB, tt = r % TB; const bool c = tt < 256; v = c ? 8 : b;
      if (mode == 0) src = c ? p.in[2] + (size_t)(b * 256 + tt) * 1024 : p.in[0] + (size_t)(b * 2048 + tt - 256) * 1024;
      else src = c ? ctxs + (size_t)(b * 256 + tt) * 1024 : p.out + (size_t)(b * 2048 + tt - 256) * 1024;
    }
    float4 xv[4]; float ss = 0.f;
#pragma unroll
    for (int j = 0; j < 4; ++j) {
      xv[j] = *(const float4*)(src + j * 256 + lane * 4);
      ss += xv[j].x * xv[j].x + xv[j].y * xv[j].y + xv[j].z * xv[j].z + xv[j].w * xv[j].w;
    }
    ss = wave_sum(ss);
    const float rstd = rsqrtf(ss * (1.f / 1024.f) + 1e-6f);
    const float* sh = mod + (size_t)v * 6144 + shift_idx * 1024;
    const float* sc = sh + 1024;
#pragma unroll
    for (int j = 0; j < 4; ++j) {
      const int c0 = j * 256 + lane * 4;
      const float4 gg = *(const float4*)(g + c0), s4 = *(const float4*)(sh + c0), c4 = *(const float4*)(sc + c0);
      const float y0 = xv[j].x * rstd * gg.x * (1.f + c4.x) + s4.x;
      const float y1 = xv[j].y * rstd * gg.y * (1.f + c4.y) + s4.y;
      const float y2 = xv[j].z * rstd * gg.z * (1.f + c4.z) + s4.z;
      const float y3 = xv[j].w * rstd * gg.w * (1.f + c4.w) + s4.w;
      uint2 o; o.x = pack2(y0, y1); o.y = pack2(y2, y3);
      *(uint2*)(h + (size_t)r * 1024 + c0) = o;
    }
  }
}

__device__ __forceinline__ float* xs_tile(const Params& p, int mt) {
  const int b = mt / 18, cc = mt % 18;
  return cc < 2 ? (float*)(p.ws + OFF_CTXS) + (size_t)(b * 256 + cc * 128) * 1024 : p.out + (size_t)(b * 2048 + (cc - 2) * 128) * 1024;
}
__device__ __forceinline__ const float* xin_tile(const Params& p, int mt) {
  const int b = mt / 18, cc = mt % 18;
  return cc < 2 ? p.in[2] + (size_t)(b * 256 + cc * 128) * 1024 : p.in[0] + (size_t)(b * 2048 + (cc - 2) * 128) * 1024;
}

__device__ __forceinline__ void l0_win_phase(const Params& p, int bid, int G) {
  WAVE_IDS
  const bf16_t* h = (const bf16_t*)(p.ws + OFF_H);
  const bf16_t* wt = (const bf16_t*)(p.ws + W0_IN);
  bf16_t* ug = (bf16_t*)(p.ws + OFF_UG);
  bf16_t* xm = (bf16_t*)(p.ws + OFF_XM);
  bf16_t* og = (bf16_t*)(p.ws + OFF_OG);
  float* gates = (float*)(p.ws + OFF_GATES);
  for (int t = bid; t < 144 * 13; t += G) {
    const int mt = t / 13, nt = t % 13;
    f32x16 acc[2][2]; ACC_ZERO(acc)
    gemm_pf2(acc, h + (size_t)mt * 128 * 1024, 1024, wt + (size_t)nt * 128 * 1024, 1024, 1024, nullptr);
    EPI_LOOP {
      const int R = mt * 128 + EPI_ROW, col = nt * 128 + EPI_COL;
      const float v = acc[i_][j_][r_];
      if (col < 512) ug[((size_t)(col >> 4) * NT + R) * 16 + (col & 15)] = f2bf(v);
      else if (col < 1024) xm[(size_t)R * 512 + col - 512] = f2bf(v);
      else if (col < 1536) og[(size_t)R * 512 + col - 1024] = f2bf(v);
      else if (col < 1552) gates[(size_t)R * 16 + col - 1536] = v;
    }
  }
}

#define STASH_LD 132
__device__ __forceinline__ void stash_acc(f32x16 (&acc)[2][2]) {
  WAVE_IDS
  float* sf = (float*)g_sm;
  EPI_LOOP { sf[EPI_ROW * STASH_LD + EPI_COL] = acc[i_][j_][r_]; }
  __syncthreads();
}
__device__ __forceinline__ void s5_x_phase(const Params& p, int bid, int G) {
  WAVE_IDS
  const bf16_t* ug = (const bf16_t*)(p.ws + OFF_UG);
  const bf16_t* G2 = (const bf16_t*)(p.ws + OFF_G2);
  float* X = (float*)(p.ws + OFF_X);
  for (int t = bid; t < 320; t += G) {
    const int g = t / 10, mt = (t % 10) >> 1, nt = t & 1;
    f32x16 acc[2][2]; ACC_ZERO(acc)
    gemm_pf2(acc, ug + (size_t)g * NT * 16 + (size_t)mt * 128 * 512, 512, G2 + ((size_t)g * 256 + nt * 128) * 512, 512, 512, nullptr);
    EPI_LOOP {
      const int rr = mt * 128 + EPI_ROW;
      if (rr < 576) X[((size_t)g * 576 + rr) * 256 + nt * 128 + EPI_COL] = acc[i_][j_][r_];
    }
  }
}

__device__ __forceinline__ void s5_scan_phase(const Params& p, int gt, int ngt) {
  const float* X = (const float*)(p.ws + OFF_X);
  bf16_t* Sin = (bf16_t*)(p.ws + OFF_SIN);
  for (int idx = gt; idx < 8 * 32 * 2 * 64; idx += ngt) {
    const int pp = idx & 63, dir = (idx >> 6) & 1, g = (idx >> 7) & 31, b = idx >> 12;
    float ar, ai; s5_apow(p, dir, g, pp, 32.f, ar, ai);
    float sr = 0.f, si = 0.f;
    const size_t gb = ((size_t)g * 576 + b * 72) * 256 + dir * 128 + pp;
#pragma unroll 1
    for (int s0 = 0; s0 < 72; s0 += 8) {
      float xr[8], xi[8];
#pragma unroll
      for (int u = 0; u < 8; ++u) {
        const int st = s0 + u, n = dir ? (st < 8 ? 7 - st : 79 - st) : st;
        xr[u] = X[gb + (size_t)n * 256]; xi[u] = X[gb + (size_t)n * 256 + 64];
      }
#pragma unroll
      for (int u = 0; u < 8; ++u) {
        const int st = s0 + u, n = dir ? (st < 8 ? 7 - st : 79 - st) : st;
        Sin[gb + (size_t)n * 256] = f2bf(sr); Sin[gb + (size_t)n * 256 + 64] = f2bf(si);
        const float nr = ar * sr - ai * si + xr[u], ni = ar * si + ai * sr + xi[u];
        sr = nr; si = ni;
      }
    }
  }
}

__device__ __forceinline__ void s5_y_phase(const Params& p, int bid, int G) {
  WAVE_IDS
  const bf16_t* ug = (const bf16_t*)(p.ws + OFF_UG);
  const bf16_t* Mm = (const bf16_t*)(p.ws + OFF_MM);
  const bf16_t* Sin = (const bf16_t*)(p.ws + OFF_SIN);
  const bf16_t* E = (const bf16_t*)(p.ws + OFF_E);
  bf16_t* gy = (bf16_t*)(p.ws + OFF_GY);
  for (int t = bid; t < 640; t += G) {
    const int g = t / 20, mt = (t % 20) >> 2, nt = t & 3;
    f32x16 acc[2][2]; ACC_ZERO(acc)
    gemm_pf2(acc, ug + (size_t)g * NT * 16 + (size_t)mt * 128 * 512, 512, Mm + ((size_t)g * 512 + nt * 128) * 512, 512, 512, nullptr);
    gemm_pf2(acc, Sin + ((size_t)g * 576 + mt * 128) * 256, 256, E + ((size_t)g * 512 + nt * 128) * 256, 256, 256, nullptr);
    stash_acc(acc);
    {
      const float* sfr = (const float*)g_sm;
#pragma unroll
      for (int it = 0; it < 4; ++it) {
        const int e = it * 256 + tid, row = e >> 3, t8 = e & 7;
        const int rr = mt * 128 + row;
        if (rr < 576) {
          const float* sp = sfr + row * STASH_LD + t8 * 16;
          const float4 a0 = *(const float4*)sp, a1 = *(const float4*)(sp + 4), a2 = *(const float4*)(sp + 8), a3 = *(const float4*)(sp + 12);
          uint4 o0, o1;
          o0.x = pack2(gelu_tanh(a0.x), gelu_tanh(a0.y)); o0.y = pack2(gelu_tanh(a0.z), gelu_tanh(a0.w));
          o0.z = pack2(gelu_tanh(a1.x), gelu_tanh(a1.y)); o0.w = pack2(gelu_tanh(a1.z), gelu_tanh(a1.w));
          o1.x = pack2(gelu_tanh(a2.x), gelu_tanh(a2.y)); o1.y = pack2(gelu_tanh(a2.z), gelu_tanh(a2.w));
          o1.z = pack2(gelu_tanh(a3.x), gelu_tanh(a3.y)); o1.w = pack2(gelu_tanh(a3.z), gelu_tanh(a3.w));
          bf16_t* dst = gy + ((size_t)rr * 32 + nt * 8 + t8) * 512 + g * 16;
          *(uint4*)dst = o0; *(uint4*)(dst + 8) = o1;
        }
      }
    }
    __syncthreads();
  }
}

__device__ __forceinline__ void glu_phase(const Params& p, int bid, int G) {
  WAVE_IDS
  const bf16_t* gy = (const bf16_t*)(p.ws + OFF_GY);
  const bf16_t* wt = (const bf16_t*)(p.ws + W0_GLU);
  bf16_t* mix = (bf16_t*)(p.ws + OFF_H);
  const float* gb = p.in[19];
  for (int t = bid; t < 144 * 4; t += G) {
    const int mt = t >> 2, nt = t & 3;
    f32x16 acc[2][2]; ACC_ZERO(acc)
    gemm_pf2(acc, gy + (size_t)mt * 128 * 512, 512, wt + (size_t)nt * 128 * 512, 512, 512, nullptr);
    EPI_LOOP {
      const int R = mt * 128 + EPI_ROW, col = nt * 128 + EPI_COL;
      const float a = bf2f(gy[(size_t)R * 512 + col]);
      mix[(size_t)R * 1024 + col] = f2bf(a * sigmoid_f(acc[i_][j_][r_] + gb[col]));
    }
  }
}

__device__ __forceinline__ void ml_conv_phase(const Params& p, int gt, int ngt) {
  const bf16_t* xm = (const bf16_t*)(p.ws + OFF_XM);
  bf16_t* xc = (bf16_t*)(p.ws + OFF_XC);
  const float* cw = p.in[20]; const float* cb = p.in[21];
  for (int idx = gt; idx < NT * 64; idx += ngt) {
    const int R = idx >> 6, c0 = (idx & 63) * 8;
    const int tt = R % TB;
    const int lo = tt < 256 ? 0 : 256, hi = tt < 256 ? 256 : TB;
    float a[8];
#pragma unroll
    for (int e = 0; e < 8; ++e) a[e] = cb[c0 + e];
#pragma unroll
    for (int k = 0; k < 5; ++k) {
      const int t2 = tt + k - 2;
      if (t2 >= lo && t2 < hi) {
        const uint4 v = *(const uint4*)(xm + (size_t)(R + k - 2) * 512 + c0);
        const float* wk = cw + k * 512 + c0;
        a[0] += wk[0] * blo(v.x); a[1] += wk[1] * bhi(v.x);
        a[2] += wk[2] * blo(v.y); a[3] += wk[3] * bhi(v.y);
        a[4] += wk[4] * blo(v.z); a[5] += wk[5] * bhi(v.z);
        a[6] += wk[6] * blo(v.w); a[7] += wk[7] * bhi(v.w);
      }
    }
    uint4 o;
    o.x = pack2(silu_f(a[0]), silu_f(a[1])); o.y = pack2(silu_f(a[2]), silu_f(a[3]));
    o.z = pack2(silu_f(a[4]), silu_f(a[5])); o.w = pack2(silu_f(a[6]), silu_f(a[7]));
    *(uint4*)(xc + (size_t)R * 512 + c0) = o;
  }
}

__device__ __forceinline__ void ml_gate_phase(const Params& p, int gw, int nw) {
  const int lane = threadIdx.x & 63;
  const float* gates = (const float*)(p.ws + OFF_GATES);
  const float* gb = p.in[25];
  float* Bc = (float*)(p.ws + OFF_BC); float* Aa = (float*)(p.ws + OFF_AA); float* PM = (float*)(p.ws + OFF_PM);
  float* BL = (float*)(p.ws + OFF_BL); float* AM = (float*)(p.ws + OFF_AM);
  for (int it = gw; it < 64 * 18; it += nw) {
    const int cc = it % 18, chain = it / 18, dir = chain & 1, hh = (chain >> 1) & 3, b = chain >> 3;
    const int p0 = 2 * lane, p1 = 2 * lane + 1;
    const int t0 = dir ? 127 - p0 : p0, t1 = dir ? 127 - p1 : p1;
    const size_t R0 = (size_t)b * TB + cc * 128 + t0, R1 = (size_t)b * TB + cc * 128 + t1;
    const float i0 = gates[R0 * 16 + dir * 8 + hh] + gb[dir * 8 + hh], i1 = gates[R1 * 16 + dir * 8 + hh] + gb[dir * 8 + hh];
    const float f0 = gates[R0 * 16 + dir * 8 + 4 + hh] + gb[dir * 8 + 4 + hh], f1 = gates[R1 * 16 + dir * 8 + 4 + hh] + gb[dir * 8 + 4 + hh];
    const float l0 = logsigmoid_f(f0), l1 = logsigmoid_f(f1);
    float incl = l0 + l1;
#pragma unroll
    for (int o = 1; o < 64; o <<= 1) { const float n = __shfl_up(incl, o); if (lane >= o) incl += n; }
    const float excl = incl - (l0 + l1);
    const float b0 = excl + l0, b1 = excl + l0 + l1;
    const float a0 = i0 - b0, a1 = i1 - b1;
    float pm = fmaxf(a0, a1);
#pragma unroll
    for (int o = 1; o < 64; o <<= 1) { const float n = __shfl_up(pm, o); if (lane >= o) pm = fmaxf(pm, n); }
    float pe = __shfl_up(pm, 1); if (lane == 0) pe = -3.0e38f;
    const float pm0 = fmaxf(pe, a0), pm1 = pm;
    const size_t o0 = (size_t)chain * TB + cc * 128 + t0, o1 = (size_t)chain * TB + cc * 128 + t1;
    Bc[o0] = b0; Bc[o1] = b1; Aa[o0] = a0; Aa[o1] = a1; PM[o0] = pm0; PM[o1] = pm1;
    const float blast = __shfl(b1, 63), amax = __shfl(pm, 63);
    if (lane == 0) { BL[chain * 18 + cc] = blast; AM[chain * 18 + cc] = amax; }
  }
}

__device__ __forceinline__ void ml_qkv_phase(const Params& p, int bid, int G) {
  WAVE_IDS
  const bf16_t* xm = (const bf16_t*)(p.ws + OFF_XM);
  const bf16_t* xc = (const bf16_t*)(p.ws + OFF_XC);
  bf16_t* q = (bf16_t*)p.out;
  bf16_t* k = q + (size_t)NT * 512;
  bf16_t* kT = k + (size_t)NT * 512;
  bf16_t* vT = (bf16_t*)(p.ws + OFF_VT0);
  for (int t = bid; t < 144 * 12; t += G) {
    const int mt = t / 12, sub = t % 12, which = sub >> 2, hd = sub & 3;
    const bf16_t* A = (which < 2 ? xc : xm) + (size_t)mt * 128 * 512 + hd * 128;
    const bf16_t* Bt = (const bf16_t*)(p.ws + (which == 0 ? W0_Q : which == 1 ? W0_K : W0_V)) + (size_t)hd * 16384;
    f32x16 acc[2][2]; ACC_ZERO(acc)
    gemm_seg(acc, A, 512, Bt, 128, 128, nullptr);
    const int b = mt / 18, tt0 = (mt % 18) * 128;
    if (which < 2) {
      bf16_t* dst = which == 0 ? q : k;
      EPI_LOOP { dst[(size_t)(mt * 128 + EPI_ROW) * 512 + hd * 128 + EPI_COL] = f2bf(acc[i_][j_][r_]); }
    }
    if (which >= 1) {
      bf16_t* dT = (which == 1 ? kT : vT) + (size_t)(b * 4 + hd) * 128 * TB;
      {
        float* sfw = (float*)g_sm;
        EPI_LOOP { sfw[EPI_ROW * 129 + EPI_COL] = acc[i_][j_][r_]; }
        __syncthreads();
#pragma unroll 2
        for (int it = 0; it < 8; ++it) {
          const int e = it * 256 + tid, r8 = e & 15, col = e >> 4;
          const float* sp = sfw + (r8 * 8) * 129 + col;
          uint4 o;
          o.x = pack2(sp[0], sp[129]); o.y = pack2(sp[258], sp[387]); o.z = pack2(sp[516], sp[645]); o.w = pack2(sp[774], sp[903]);
          *(uint4*)(dT + (size_t)col * TB + tt0 + r8 * 8) = o;
        }
        __syncthreads();
      }
    }
  }
}

#define P_LD 136
__device__ __forceinline__ void gemm_alds(f32x16 (&acc)[2][2], const bf16_t* __restrict__ Bt, size_t ldb) {
  const int tid = opaque_tid(), lane = tid & 63, w = tid >> 6, wm = w >> 1, wn = w & 1;
  const int lr = tid >> 3, lk = (tid & 7) * 8;
  const bf16_t* gb = Bt + (size_t)lr * ldb + lk;
  uint4 rb0 = *(const uint4*)(gb), rb1 = *(const uint4*)(gb + 32 * ldb), rb2 = *(const uint4*)(gb + 64 * ldb), rb3 = *(const uint4*)(gb + 96 * ldb);
  bf16_t* sB = g_sm + 128 * P_LD;
  const int soff = lr * LDT + lk;
  *(uint4*)(sB + soff) = rb0; *(uint4*)(sB + soff + 32 * LDT) = rb1; *(uint4*)(sB + soff + 64 * LDT) = rb2; *(uint4*)(sB + soff + 96 * LDT) = rb3;
  rb0 = *(const uint4*)(gb + 64); rb1 = *(const uint4*)(gb + 32 * ldb + 64); rb2 = *(const uint4*)(gb + 64 * ldb + 64); rb3 = *(const uint4*)(gb + 96 * ldb + 64);
  __syncthreads();
  const int aoff = (wm * 64 + (lane & 31)) * P_LD + (lane >> 5) * 8;
  const int boff = (wn * 64 + (lane & 31)) * LDT + (lane >> 5) * 8;
#pragma unroll
  for (int kt = 0; kt < 2; ++kt) {
    const bf16_t* pa = g_sm + aoff + kt * 64;
    const bf16_t* pb = sB + kt * (128 * LDT) + boff;
#pragma unroll
    for (int kk = 0; kk < 4; ++kk) {
      bf16x8 a0 = *(const bf16x8*)(pa + kk * 16);
      bf16x8 a1 = *(const bf16x8*)(pa + 32 * P_LD + kk * 16);
      bf16x8 b0 = *(const bf16x8*)(pb + kk * 16);
      bf16x8 b1 = *(const bf16x8*)(pb + 32 * LDT + kk * 16);
      acc[0][0] = __builtin_amdgcn_mfma_f32_32x32x16_bf16(a0, b0, acc[0][0], 0, 0, 0);
      acc[0][1] = __builtin_amdgcn_mfma_f32_32x32x16_bf16(a0, b1, acc[0][1], 0, 0, 0);
      acc[1][0] = __builtin_amdgcn_mfma_f32_32x32x16_bf16(a1, b0, acc[1][0], 0, 0, 0);
      acc[1][1] = __builtin_amdgcn_mfma_f32_32x32x16_bf16(a1, b1, acc[1][1], 0, 0, 0);
    }
    if (kt == 0) {
      bf16_t* dB = sB + 128 * LDT + soff;
      *(uint4*)(dB) = rb0; *(uint4*)(dB + 32 * LDT) = rb1; *(uint4*)(dB + 64 * LDT) = rb2; *(uint4*)(dB + 96 * LDT) = rb3;
    }
    __syncthreads();
  }
}
__device__ __forceinline__ void scores_to_lds(f32x16 (&acc)[2][2], int dir, bool strict) {
  WAVE_IDS
  const float* s_alpha = g_sf; const float* s_beta = g_sf + 128;
  EPI_LOOP {
    const int t = EPI_ROW, s = EPI_COL;
    const int pt = dir ? 127 - t : t, ps = dir ? 127 - s : s;
    const bool ok = strict ? (ps < pt) : (ps <= pt);
    const float v = ok ? acc[i_][j_][r_] * __expf(s_alpha[s] - s_beta[t]) : 0.f;
    g_sm[t * P_LD + s] = f2bf(v);
  }
  __syncthreads();
}
__device__ __forceinline__ void atomic_add_bf16x2(unsigned* addr, float a, float b) {
  unsigned old = __atomic_load_n(addr, __ATOMIC_RELAXED);
  while (true) {
    const unsigned nw = pack2(blo(old) + a, bhi(old) + b);
    const unsigned prev = atomicCAS(addr, old, nw);
    if (prev == old) break;
    old = prev;
  }
}

__device__ __forceinline__ void ret_scores_phase(const Params& p, int bid, int G) {
  WAVE_IDS
  const bf16_t* q = (const bf16_t*)(p.ws + L1_Q);
  bf16_t* k = (bf16_t*)(p.ws + L1_K);
  for (int t = bid; t < 512; t += G) {
    const int hd = t & 3, c = (t >> 2) & 15, b = t >> 6;
    const size_t base = ((size_t)b * 2048 + c * 128) * 1024 + hd * 256;
    const float lgf = p.in[29][hd], lgb = p.in[29][4 + hd];
    f32x16 acc[2][2]; ACC_ZERO(acc)
    gemm_pf2(acc, q + base, 1024, k + base, 1024, 256, nullptr);
    stash_acc(acc);
    {
      const float* sf = (const float*)g_sm;
#pragma unroll 2
      for (int e = tid; e < 4096; e += 256) {
        const int tq = e >> 5, s0 = (e & 31) * 4;
        const float4 v = *(const float4*)(sf + tq * STASH_LD + s0);
        float vv[4] = {v.x, v.y, v.z, v.w}, pf[4], pb[4];
#pragma unroll
        for (int u = 0; u < 4; ++u) {
          const int sk = s0 + u; const float d = (float)(tq - sk);
          pf[u] = (sk <= tq) ? vv[u] * __expf(lgf * d) : 0.f;
          pb[u] = (sk > tq) ? vv[u] * __expf(-lgb * d) : 0.f;
        }
        bf16_t* dst = k + base + (size_t)tq * 1024 + s0;
        uint2 wf, wb; wf.x = pack2(pf[0], pf[1]); wf.y = pack2(pf[2], pf[3]); wb.x = pack2(pb[0], pb[1]); wb.y = pack2(pb[2], pb[3]);
        *(uint2*)dst = wf; *(uint2*)(dst + 128) = wb;
      }
    }
    __syncthreads();
  }
}

__device__ __forceinline__ void ret_chain_item(const Params& p, int item) {
  const int tid = opaque_tid();
  const int dir = item & 1, vs = (item >> 1) & 3, hd = (item >> 3) & 3, b = item >> 5;
  const bf16_t* qb = (const bf16_t*)(p.ws + L1_Q) + (size_t)b * 2048 * 1024 + hd * 256;
  const bf16_t* kb = (const bf16_t*)(p.ws + L1_K) + (size_t)b * 2048 * 1024 + hd * 256;
  const bf16_t* kT = (const bf16_t*)(p.ws + L1_KT) + (size_t)(b * 4 + hd) * 256 * TB;
  const bf16_t* vT = (const bf16_t*)(p.ws + L1_VT) + ((size_t)(b * 4 + hd) * 512 + vs * 128) * TB;
  bf16_t* Sbf = (bf16_t*)(p.ws + (item < 152 ? L1_P + (size_t)item * 65536 : OFF_ROPE + (size_t)(item - 152) * 65536));
  bf16_t* o = (bf16_t*)(p.ws + L1_O) + (size_t)b * 2048 * 2048 + hd * 512 + vs * 128;
  const float lg = p.in[29][dir * 4 + hd];
  const bool strict = dir == 1;
  const float* sf = (const float*)g_sm;
  float* s_alpha = g_sf, *s_beta = g_sf + 128, *s_rse = g_sf + 256, *s_wexp = g_sf + 384;
  __syncthreads();
  for (int e = tid; e < 128 * 256 / 8; e += 256) *(uint4*)(Sbf + e * 8) = make_uint4(0, 0, 0, 0);
  if (tid < 128) {
    const float pp = dir ? (float)(127 - tid) : (float)tid;
    s_alpha[tid] = -lg * pp; s_beta[tid] = -lg * pp; s_rse[tid] = __expf(lg * (pp + 1.f)); s_wexp[tid] = __expf(lg * (127.f - pp));
  }
  const float dec = __expf(128.f * lg);
  __threadfence_block();
  __syncthreads();
#pragma unroll 1
  for (int st = 0; st < 18; ++st) {
    const int cc = dir ? (st == 0 ? 1 : st == 1 ? 0 : 19 - st) : st;
    const int tt0 = cc * 128;
    if (cc >= 2) {
      const bf16_t* qc = qb + (size_t)(tt0 - 256) * 1024;
      const bf16_t* kc = kb + (size_t)(tt0 - 256) * 1024;
      {
        f32x16 acc[2][2]; ACC_ZERO(acc)
        gemm_seg(acc, kc + dir * 128, 1024, vT + tt0, TB, 128, nullptr);
        gemm_seg(acc, qc, 1024, Sbf, 256, 256, nullptr, s_rse);
        stash_acc(acc);
      }
#pragma unroll 4
      for (int it = 0; it < 32; ++it) {
        const int wd = it * 256 + tid, t = wd >> 6, wc = wd & 63;
        const float2 v = *(const float2*)(sf + t * STASH_LD + 2 * wc);
        short2v pk; pk[0] = (short)f2bf(v.x); pk[1] = (short)f2bf(v.y);
        __builtin_amdgcn_global_atomic_fadd_v2bf16((__attribute__((address_space(1))) short2v*)(o + (size_t)(tt0 - 256 + t) * 2048 + 2 * wc), pk);
      }
    }
#pragma unroll 1
    for (int nt = 0; nt < 2; ++nt) {
      {
        f32x16 acc[2][2]; ACC_ZERO(acc)
        gemm_seg(acc, vT + tt0, TB, kT + (size_t)nt * 128 * TB + tt0, TB, 128, s_wexp);
        stash_acc(acc);
      }
#pragma unroll 8
      for (int e = tid; e < 4096; e += 256) {
        const int v = e >> 5, k0 = nt * 128 + (e & 31) * 4;
        const float4 a = *(const float4*)(sf + v * STASH_LD + (e & 31) * 4);
        const uint2 old = *(const uint2*)(Sbf + v * 256 + k0);
        uint2 w2;
        w2.x = pack2(dec * blo(old.x) + a.x, dec * bhi(old.x) + a.y);
        w2.y = pack2(dec * blo(old.y) + a.z, dec * bhi(old.y) + a.w);
        *(uint2*)(Sbf + v * 256 + k0) = w2;
      }
    }
    __threadfence_block();
    __syncthreads();
  }
}

__device__ __forceinline__ void ml_prefix_phase(const Params& p, int bid, int G) {
  const int tid = opaque_tid();
  const float* Aa = (const float*)(p.ws + OFF_AA);
  const float* BL = (const float*)(p.ws + OFF_BL); const float* AM = (const float*)(p.ws + OFF_AM);
  float* Gs = (float*)(p.ws + OFF_GS); float* MU = (float*)(p.ws + OFF_MU); float* MN = (float*)(p.ws + OFF_MN);
  for (int chain = bid; chain < 64; chain += G) {
    const int dir = chain & 1;
    __syncthreads();
    if (tid == 0) {
      float F = 0.f, mu = 0.f;
      for (int st = 0; st < 18; ++st) {
        const int cc = dir ? (st == 0 ? 1 : st == 1 ? 0 : 19 - st) : st;
        g_sf[cc] = F;
        MU[chain * 18 + st] = mu; MN[chain * 18 + st] = mu + F;
        mu = fmaxf(mu, AM[chain * 18 + cc] - F);
        F += BL[chain * 18 + cc];
      }
    }
    __syncthreads();
    for (int tt = tid; tt < TB; tt += 256) Gs[(size_t)chain * TB + tt] = Aa[(size_t)chain * TB + tt] - g_sf[tt >> 7];
  }
}

__device__ __forceinline__ void ml_unit(const Params& p, int chain, int st, bf16_t* Sbf) {
  const int tid = opaque_tid();
  const int dir = chain & 1, hd = (chain >> 1) & 3, b = chain >> 3;
  const int cc = dir ? (st == 0 ? 1 : st == 1 ? 0 : 19 - st) : st;
  const int tt0 = cc * 128;
  const bf16_t* q = (const bf16_t*)p.out;
  const bf16_t* k = q + (size_t)NT * 512;
  const bf16_t* kT = k + (size_t)NT * 512 + (size_t)(b * 4 + hd) * 128 * TB;
  const bf16_t* vT = (const bf16_t*)(p.ws + OFF_VT0) + (size_t)(b * 4 + hd) * 128 * TB;
  const bf16_t* qc = q + ((size_t)b * TB + tt0) * 512 + hd * 128;
  const bf16_t* kc = k + ((size_t)b * TB + tt0) * 512 + hd * 128;
  const float* Gs = (const float*)(p.ws + OFF_GS) + (size_t)chain * TB;
  const float mu = ((const float*)(p.ws + OFF_MU))[chain * 18 + st];
  const float m_in = ((const float*)(p.ws + OFF_MN))[chain * 18 + st];
  const float* Bc = (const float*)(p.ws + OFF_BC) + (size_t)chain * TB;
  const float* Aa = (const float*)(p.ws + OFF_AA) + (size_t)chain * TB;
  const float* PMx = (const float*)(p.ws + OFF_PM) + (size_t)chain * TB;
  bf16_t* hout = (bf16_t*)(p.ws + OFF_HDIR) + (size_t)dir * NT * 512 + ((size_t)b * TB + tt0) * 512 + hd * 128;
  const float* sf = (const float*)g_sm;
  float* s_alpha = g_sf, *s_beta = g_sf + 128, *s_rse = g_sf + 256, *s_den = g_sf + 512, *s_mexp = g_sf + 640, *s_n = g_sf + 768, *s_red = g_sf + 896;
  int r0 = 0, len0 = 0, r1 = 0, len1 = 0;
  if (!dir) { len0 = 128 * st; }
  else if (st == 1) { r0 = 128; len0 = 128; }
  else if (st >= 2) { r0 = 0; len0 = 256; r1 = (20 - st) * 128; len1 = TB - r1; }
  __syncthreads();
  if (st > 0) {
    {
      f32x16 acc[2][2]; ACC_ZERO(acc)
      gemm_seg<2>(acc, vT + r0, TB, kT + r0, TB, len0, Gs + r0, nullptr, mu);
      if (len1 > 0) gemm_seg<2>(acc, vT + r1, TB, kT + r1, TB, len1, Gs + r1, nullptr, mu);
      stash_acc(acc);
    }
#pragma unroll 1
    for (int e = tid; e < 4096; e += 256) {
      const int v = e >> 5, k0 = (e & 31) * 4;
      const float4 a = *(const float4*)(sf + v * STASH_LD + k0);
      uint2 w2; w2.x = pack2(a.x, a.y); w2.y = pack2(a.z, a.w);
      *(uint2*)(Sbf + v * 128 + k0) = w2;
    }
    __syncthreads();
    float* wl = (float*)g_sm;
    const int lent = len0 + len1;
    for (int i = tid; i < lent; i += 256) wl[i] = __expf(Gs[i < len0 ? r0 + i : r1 + i - len0] - mu);
    __syncthreads();
    {
      const int kk = tid & 127, half = tid >> 7, hl = lent >> 1;
      const bf16_t* kr = kT + (size_t)kk * TB;
      float s = 0.f;
#pragma unroll 2
      for (int i = half * hl; i < (half + 1) * hl; i += 8) {
        const uint4 kv = *(const uint4*)(kr + (i < len0 ? r0 + i : r1 + i - len0));
        const float* ww = wl + i;
        s += ww[0] * blo(kv.x) + ww[1] * bhi(kv.x) + ww[2] * blo(kv.y) + ww[3] * bhi(kv.y) + ww[4] * blo(kv.z) + ww[5] * bhi(kv.z) + ww[6] * blo(kv.w) + ww[7] * bhi(kv.w);
      }
      s_red[tid] = s;
    }
    __syncthreads();
    if (tid < 128) s_n[tid] = s_red[tid] + s_red[tid + 128];
  } else {
    if (tid < 128) s_n[tid] = 0.f;
  }
  if (tid < 128) {
    const int t = tid;
    const float a = Aa[tt0 + t], be = fmaxf(m_in, PMx[tt0 + t]);
    s_alpha[t] = a; s_beta[t] = be; s_rse[t] = __expf(m_in - be);
    s_mexp[t] = __expf(-(Bc[tt0 + t] + be));
  }
  __threadfence_block();
  __syncthreads();
  {
    f32x16 acc[2][2]; ACC_ZERO(acc)
    gemm_seg(acc, qc, 512, kc, 512, 128, nullptr);
    scores_to_lds(acc, dir, false);
  }
  if (tid < 128) {
    const int t = tid; float sum = 0.f, qn = 0.f;
    const uint4* pr = (const uint4*)(g_sm + t * P_LD);
    const uint4* qr = (const uint4*)(qc + (size_t)t * 512);
#pragma unroll 2
    for (int e = 0; e < 16; ++e) {
      const uint4 pv = pr[e], qv = qr[e];
      sum += blo(pv.x) + bhi(pv.x) + blo(pv.y) + bhi(pv.y) + blo(pv.z) + bhi(pv.z) + blo(pv.w) + bhi(pv.w);
      const float* nn = s_n + e * 8;
      qn += blo(qv.x) * nn[0] + bhi(qv.x) * nn[1] + blo(qv.y) * nn[2] + bhi(qv.y) * nn[3] + blo(qv.z) * nn[4] + bhi(qv.z) * nn[5] + blo(qv.w) * nn[6] + bhi(qv.w) * nn[7];
    }
    s_den[t] = sum + s_rse[t] * qn;
  }
  {
    f32x16 acc[2][2]; ACC_ZERO(acc)
    gemm_alds(acc, vT + tt0, TB);
    if (st > 0) gemm_seg(acc, qc, 512, Sbf, 128, 128, nullptr, s_rse);
    stash_acc(acc);
  }
#pragma unroll 1
  for (int e = tid; e < 4096; e += 256) {
    const int t = e >> 5, c0 = (e & 31) * 4;
    const float4 v = *(const float4*)(sf + t * STASH_LD + c0);
    const float sc = 1.f / fmaxf(fabsf(s_den[t]), s_mexp[t]);
    uint2 w2; w2.x = pack2(v.x * sc, v.y * sc); w2.y = pack2(v.z * sc, v.w * sc);
    *(uint2*)(hout + (size_t)t * 512 + c0) = w2;
  }
  __syncthreads();
}
__device__ __forceinline__ void ml_units_phase(const Params& p, int bid, int G) {
  bf16_t* Sbf = (bf16_t*)(p.ws + OFF_X) + (size_t)bid * 16384;
  if (G == 512) {
    { const int u = bid; ml_unit(p, u & 63, 17 - (u >> 6), Sbf); }
    { const int u = 1023 - bid; ml_unit(p, u & 63, 17 - (u >> 6), Sbf); }
    if (bid < 128) { const int u = 1024 + bid; ml_unit(p, u & 63, 17 - (u >> 6), Sbf); }
  } else {
    for (int u = bid; u < 1152; u += G) ml_unit(p, u & 63, 17 - (u >> 6), Sbf);
  }
}

__device__ __forceinline__ void ml_finish_phase(const Params& p, int gw, int nw) {
  const int lane = threadIdx.x & 63;
  const bf16_t* h0 = (const bf16_t*)(p.ws + OFF_HDIR);
  const bf16_t* h1 = h0 + (size_t)NT * 512;
  const bf16_t* og = (const bf16_t*)(p.ws + OFF_OG);
  bf16_t* mix = (bf16_t*)(p.ws + OFF_H);
  const float* ng = p.in[26];
  for (int it = gw; it < NT * 4; it += nw) {
    const int R = it >> 2, hd = it & 3;
    const size_t o = (size_t)R * 512 + hd * 128 + lane * 2;
    const unsigned a = *(const unsigned*)(h0 + o), bq = *(const unsigned*)(h1 + o), g2 = *(const unsigned*)(og + o);
    const float v0 = blo(a) + blo(bq), v1 = bhi(a) + bhi(bq);
    const float mu = wave_sum(v0 + v1) * (1.f / 128.f);
    const float d0 = v0 - mu, d1 = v1 - mu;
    const float var = wave_sum(d0 * d0 + d1 * d1) * (1.f / 128.f);
    const float rs = rsqrtf(var + 1e-6f);
    const float y0 = d0 * rs * ng[hd * 128 + lane * 2] * sigmoid_f(blo(g2));
    const float y1 = d1 * rs * ng[hd * 128 + lane * 2 + 1] * sigmoid_f(bhi(g2));
    *(unsigned*)(mix + (size_t)R * 1024 + 512 + hd * 128 + lane * 2) = pack2(y0, y1);
  }
}

__device__ __forceinline__ void l0_wout_phase(const Params& p, int bid, int G) {
  WAVE_IDS
  const bf16_t* mix = (const bf16_t*)(p.ws + OFF_H);
  const bf16_t* wt = (const bf16_t*)(p.ws + W0_OUT);
  const float* mod = (const float*)(p.ws + OFF_MOD);
  for (int t = bid; t < 144 * 8; t += G) {
    const int mt = t >> 3, nt = t & 7;
    f32x16 acc[2][2]; ACC_ZERO(acc)
    gemm_pf2(acc, mix + (size_t)mt * 128 * 1024, 1024, wt + (size_t)nt * 128 * 1024, 1024, 1024, nullptr);
    const int v = (mt % 18) < 2 ? 8 : mt / 18;
    const float* gate = mod + (size_t)v * 6144 + 2 * 1024;
    const float* xi = xin_tile(p, mt); float* xo = xs_tile(p, mt);
    EPI_LOOP {
      const int row = EPI_ROW, col = nt * 128 + EPI_COL;
      xo[(size_t)row * 1024 + col] = xi[(size_t)row * 1024 + col] + gate[col] * acc[i_][j_][r_];
    }
  }
}

__device__ __forceinline__ void ffn1_phase(const Params& p, const bf16_t* h, const bf16_t* w13, bf16_t* hid, int ntm, int bid, int G) {
  WAVE_IDS
  const int ntm2 = ntm >> 1;
  const int nbig = ntm2 * 44;
  const int nfull = (nbig / G) * G;
  for (int t = bid; t < nfull; t += G) {
    const int mt = t / 44, nt = t % 44;
    f32x16 acc[4][2]; ACC4_ZERO(acc)
    gemm_m256(acc, h + (size_t)mt * 256 * 1024, 1024, w13 + (size_t)nt * 128 * 1024, 1024, 1024);
#pragma unroll
    for (int i_ = 0; i_ < 4; ++i_)
#pragma unroll
      for (int r_ = 0; r_ < 16; ++r_) {
        const int row = wm * 128 + i_ * 32 + (r_ & 3) + 8 * (r_ >> 2) + 4 * (lane >> 5);
        const float gv = acc[i_][0][r_], uv = acc[i_][1][r_];
        hid[(size_t)(mt * 256 + row) * 2816 + nt * 64 + wn * 32 + (lane & 31)] = f2bf(silu_f(gv) * uv);
      }
  }
  const int nsmall = (nbig - nfull) * 2;
  for (int u = bid; u < nsmall; u += G) {
    const int tb = nfull + (u >> 1), mt = (tb / 44) * 2 + (u & 1), nt = tb % 44;
    f32x16 acc[2][2]; ACC_ZERO(acc)
    gemm_pf2(acc, h + (size_t)mt * 128 * 1024, 1024, w13 + (size_t)nt * 128 * 1024, 1024, 1024, nullptr);
#pragma unroll
    for (int i_ = 0; i_ < 2; ++i_)
#pragma unroll
      for (int r_ = 0; r_ < 16; ++r_) {
        const int row = wm * 64 + i_ * 32 + (r_ & 3) + 8 * (r_ >> 2) + 4 * (lane >> 5);
        const float gv = acc[i_][0][r_], uv = acc[i_][1][r_];
        hid[(size_t)(mt * 128 + row) * 2816 + nt * 64 + wn * 32 + (lane & 31)] = f2bf(silu_f(gv) * uv);
      }
  }
}
#define EPI4_LOOP_SB                                    \
  _Pragma("unroll") for (int i_ = 0; i_ < 4; ++i_)      \
  _Pragma("unroll") for (int j_ = 0; j_ < 2; ++j_)      \
  _Pragma("unroll") for (int r_ = 0; r_ < 16; ++r_)     \
    if ((r_ & 7) == 0 ? (__builtin_amdgcn_sched_barrier(0), true) : true)
__device__ __forceinline__ void ffn2_phase(const Params& p, const bf16_t* hid, const bf16_t* w2, int layer, bool latonly, int bid, int G) {
  WAVE_IDS
  const float* mod = (const float*)(p.ws + OFF_MOD) + (size_t)layer * 9 * 6144;
  for (int t = bid; t < 64 * 8; t += G) {
    const int lm = t >> 3, nt = t & 7, b = lm >> 3;
    const size_t hrow = latonly ? (size_t)lm * 256 : (size_t)b * TB + 256 + (size_t)(lm & 7) * 256;
    f32x16 acc[4][2]; ACC4_ZERO(acc)
    gemm_m256(acc, hid + hrow * 2816, 2816, w2 + (size_t)nt * 128 * 2816, 2816, 2816);
    const float* gate = mod + (size_t)b * 6144 + 5 * 1024;
    float* xo = p.out + (size_t)lm * 256 * 1024;
#pragma unroll
    for (int hh = 0; hh < 2; ++hh) {
      {
        float* sfw = (float*)g_sm;
#pragma unroll
        for (int ii = 0; ii < 2; ++ii)
#pragma unroll
          for (int j_ = 0; j_ < 2; ++j_)
#pragma unroll
            for (int r_ = 0; r_ < 16; ++r_)
              sfw[(wm * 64 + ii * 32 + (r_ & 3) + 8 * (r_ >> 2) + 4 * (lane >> 5)) * STASH_LD + EPI_COL] = acc[hh * 2 + ii][j_][r_];
      }
      __syncthreads();
      const float* sfr = (const float*)g_sm;
#pragma unroll 4
      for (int e = tid; e < 4096; e += 256) {
        const int sr = e >> 5, c0 = (e & 31) * 4;
        const int row = (sr >> 6) * 128 + hh * 64 + (sr & 63);
        const float4 a = *(const float4*)(sfr + sr * STASH_LD + c0);
        const float4 gg = *(const float4*)(gate + nt * 128 + c0);
        float4* dst = (float4*)(xo + (size_t)row * 1024 + nt * 128 + c0);
        float4 o = *dst;
        o.x += gg.x * a.x; o.y += gg.y * a.y; o.z += gg.z * a.z; o.w += gg.w * a.w;
        *dst = o;
      }
      __syncthreads();
    }
  }
  if (!latonly) {
    for (int t = G - 1 - bid; t < 16 * 8; t += G) {
      const int ci = t >> 3, nt = t & 7, mt = (ci >> 1) * 18 + (ci & 1);
      f32x16 acc[2][2]; ACC_ZERO(acc)
      gemm_pf2(acc, hid + (size_t)mt * 128 * 2816, 2816, w2 + (size_t)nt * 128 * 2816, 2816, 2816, nullptr);
      const float* gate = mod + (size_t)8 * 6144 + 5 * 1024;
      float* xo = xs_tile(p, mt);
      EPI_LOOP {
        const int row = EPI_ROW, col = nt * 128 + EPI_COL;
        xo[(size_t)row * 1024 + col] += gate[col] * acc[i_][j_][r_];
      }
    }
  }
}

__device__ __forceinline__ void ret_in_phase(const Params& p, int bid, int G) {
  WAVE_IDS
  const bf16_t* h = (const bf16_t*)(p.ws + L1_H);
  const bf16_t* wt = (const bf16_t*)(p.ws + L1_WIN);
  bf16_t* q = (bf16_t*)(p.ws + L1_Q);
  bf16_t* k = (bf16_t*)(p.ws + L1_K);
  bf16_t* kT = (bf16_t*)(p.ws + L1_KT);
  bf16_t* vT = (bf16_t*)(p.ws + L1_VT);
  const float* rc = (const float*)(p.ws + OFF_ROPE);
  const float* rs = rc + 2048 * 128;
  for (int t = bid; t < 4480; t += G) {
    int b, cc, nt;
    if (t < 4096) { const int li = t >> 5; b = li >> 4; cc = 2 + (li & 15); nt = t & 31; }
    else { const int t2 = t - 4096, ci = t2 / 24; b = ci >> 1; cc = ci & 1; nt = 8 + t2 % 24; }
    const int mt = b * 18 + cc, tt0 = cc * 128;
    f32x16 acc[2][2]; ACC_ZERO(acc)
    gemm_seg(acc, h + (size_t)mt * 128 * 1024, 1024, wt + (size_t)nt * 128 * 1024, 1024, 1024, nullptr);
    if (nt < 16) {
      if (cc >= 2) {
        const int pi = ((nt & 1) * 2 + wn) * 32 + (lane & 31);
#pragma unroll
        for (int i_ = 0; i_ < 2; ++i_)
#pragma unroll
          for (int r_ = 0; r_ < 16; ++r_) {
            const int row = wm * 64 + i_ * 32 + (r_ & 3) + 8 * (r_ >> 2) + 4 * (lane >> 5);
            const int pos = tt0 - 256 + row;
            const float c = rc[pos * 128 + pi], s = rs[pos * 128 + pi];
            const float t1 = acc[i_][0][r_], t2 = acc[i_][1][r_];
            acc[i_][0][r_] = t1 * c - t2 * s;
            acc[i_][1][r_] = t2 * c + t1 * s;
          }
      }
      if (cc >= 2) {
        bf16_t* dst = (nt < 8 ? q : k) + (size_t)(b * 2048 + tt0 - 256) * 1024 + (nt & 7) * 128;
        EPI_LOOP { dst[(size_t)EPI_ROW * 1024 + EPI_COL] = f2bf(acc[i_][j_][r_]); }
      }
    }
    if (nt >= 8) {
      bf16_t* dT;
      if (nt < 16) { const int kc = (nt - 8) * 128; dT = kT + ((size_t)(b * 4 + (kc >> 8)) * 256 + (kc & 255)) * TB; }
      else { const int vc = (nt - 16) * 128; dT = vT + ((size_t)(b * 4 + (vc >> 9)) * 512 + (vc & 511)) * TB; }
      {
        float* sfw = (float*)g_sm;
        EPI_LOOP { sfw[EPI_ROW * 129 + EPI_COL] = acc[i_][j_][r_]; }
        __syncthreads();
#pragma unroll 2
        for (int it = 0; it < 8; ++it) {
          const int e = it * 256 + tid, r8 = e & 15, col = e >> 4;
          const float* sp = sfw + (r8 * 8) * 129 + col;
          uint4 o;
          o.x = pack2(sp[0], sp[129]); o.y = pack2(sp[258], sp[387]); o.z = pack2(sp[516], sp[645]); o.w = pack2(sp[774], sp[903]);
          *(uint4*)(dT + (size_t)col * TB + tt0 + r8 * 8) = o;
        }
        __syncthreads();
      }
    }
  }
}

__device__ __forceinline__ void ret_headnorm_phase(const Params& p, int gw, int nw) {
  const int lane = threadIdx.x & 63;
  bf16_t* o = (bf16_t*)(p.ws + L1_O);
  const float* ng = p.in[30];
  for (int it = gw; it < 16384 * 4; it += nw) {
    const int R = it >> 2, hd = it & 3;
    bf16_t* ptr = o + (size_t)R * 2048 + hd * 512 + lane * 8;
    const uint4 v = *(const uint4*)ptr;
    float x[8] = {blo(v.x), bhi(v.x), blo(v.y), bhi(v.y), blo(v.z), bhi(v.z), blo(v.w), bhi(v.w)};
    float s = 0.f;
#pragma unroll
    for (int e = 0; e < 8; ++e) s += x[e];
    const float mu = wave_sum(s) * (1.f / 512.f);
    float q = 0.f;
#pragma unroll
    for (int e = 0; e < 8; ++e) { x[e] -= mu; q += x[e] * x[e]; }
    const float rs = rsqrtf(wave_sum(q) * (1.f / 512.f) + 1e-6f);
    const float* gg = ng + hd * 512 + lane * 8;
    uint4 w;
    w.x = pack2(x[0] * rs * gg[0], x[1] * rs * gg[1]); w.y = pack2(x[2] * rs * gg[2], x[3] * rs * gg[3]);
    w.z = pack2(x[4] * rs * gg[4], x[5] * rs * gg[5]); w.w = pack2(x[6] * rs * gg[6], x[7] * rs * gg[7]);
    *(uint4*)ptr = w;
  }
}

__device__ __forceinline__ void ret_gate_phase(const Params& p, int bid, int G) {
  WAVE_IDS
  const bf16_t* h = (const bf16_t*)(p.ws + L1_HL);
  const bf16_t* wt = (const bf16_t*)(p.ws + L1_WG);
  bf16_t* o = (bf16_t*)(p.ws + L1_O);
  for (int t = bid; t < 64 * 16; t += G) {
    const int mt = t >> 4, nt = t & 15;
    f32x16 acc[4][2]; ACC4_ZERO(acc)
    gemm_m256(acc, h + (size_t)mt * 256 * 1024, 1024, wt + (size_t)nt * 128 * 1024, 1024, 1024);
    EPI4_LOOP {
      bf16_t* dst = o + (size_t)(mt * 256 + EPI4_ROW) * 2048 + nt * 128 + EPI_COL;
      *dst = f2bf(silu_f(acc[i_][j_][r_]) * bf2f(*dst));
    }
  }
}

__device__ __forceinline__ void ret_wout_phase(const Params& p, int bid, int G) {
  WAVE_IDS
  const bf16_t* o = (const bf16_t*)(p.ws + L1_O);
  const bf16_t* wt = (const bf16_t*)(p.ws + L1_WOUT);
  const float* mod = (const float*)(p.ws + OFF_MOD) + (size_t)9 * 6144;
  for (int t = bid; t < 128 * 8; t += G) {
    const int mt = t >> 3, nt = t & 7;
    f32x16 acc[2][2]; ACC_ZERO(acc)
    gemm_pf2(acc, o + (size_t)mt * 128 * 2048, 2048, wt + (size_t)nt * 128 * 2048, 2048, 2048, nullptr);
    const float* gate = mod + (size_t)(mt >> 4) * 6144 + 2 * 1024;
    float* xo = p.out + (size_t)mt * 128 * 1024;
    EPI_LOOP {
      const int row = EPI_ROW, col = nt * 128 + EPI_COL;
      xo[(size_t)row * 1024 + col] += gate[col] * acc[i_][j_][r_];
    }
  }
}

__device__ __forceinline__ void final_norm_phase(const Params& p, int gw, int nw) {
  const int lane = threadIdx.x & 63;
  const float* g = p.in[34];
  for (int r = gw; r < 16384; r += nw) {
    float* src = p.out + (size_t)r * 1024;
    float4 xv[4]; float ss = 0.f;
#pragma unroll
    for (int j = 0; j < 4; ++j) {
      xv[j] = *(const float4*)(src + j * 256 + lane * 4);
      ss += xv[j].x * xv[j].x + xv[j].y * xv[j].y + xv[j].z * xv[j].z + xv[j].w * xv[j].w;
    }
    ss = wave_sum(ss);
    const float rstd = rsqrtf(ss * (1.f / 1024.f) + 1e-6f);
#pragma unroll
    for (int j = 0; j < 4; ++j) {
      const int c0 = j * 256 + lane * 4;
      const float4 gg = *(const float4*)(g + c0);
      float4 o; o.x = xv[j].x * rstd * gg.x; o.y = xv[j].y * rstd * gg.y; o.z = xv[j].z * rstd * gg.z; o.w = xv[j].w * rstd * gg.w;
      *(float4*)(src + c0) = o;
    }
  }
}

#define XB_TMO      128
#define XB_XCNT(j)  (256  + 64 * (j))
#define XB_XSUB(j)  (1280 + 64 * (j))
#define XB_XGEN(j)  (2304 + 64 * (j))
#define XB_TOP      3328
#define XB_TOPGEN   3392
#define XCD_BAR_WORDS 3456
#define XB_SPIN_CAP (1u << 18)
#define LAS __attribute__((address_space(3)))

__device__ __forceinline__ unsigned xb_ld(unsigned* p)              { return __hip_atomic_load(p, __ATOMIC_RELAXED, __HIP_MEMORY_SCOPE_AGENT); }
__device__ __forceinline__ unsigned xb_add(unsigned* p, unsigned v) { return __hip_atomic_fetch_add(p, v, __ATOMIC_RELAXED, __HIP_MEMORY_SCOPE_AGENT); }
__device__ __forceinline__ unsigned xb_xcc_id() { return (unsigned)__builtin_amdgcn_s_getreg((3 << 11) | 20) & 0xFu; }
#define XB_SPIN(cond, bar) do { unsigned _sp = 0; while (cond) { __builtin_amdgcn_s_sleep(4); \
    if ((++_sp & 255u) == 0u) { if (xb_ld(&(bar)[XB_TMO])) break; if (_sp > XB_SPIN_CAP) { atomicAdd(&(bar)[XB_TMO], 1u); break; } } } } while (0)

struct XcdBarrier {
    unsigned* bar; unsigned x;
    volatile LAS unsigned* st;
};

__device__ __forceinline__ XcdBarrier xcd_barrier_post(unsigned* bar, volatile LAS unsigned* st) {
    XcdBarrier b; b.bar = bar; b.x = xb_xcc_id(); b.st = st;
    if (threadIdx.x == 0) (void)xb_add(&bar[XB_XCNT(b.x)], 1u);
    return b;
}
__device__ __forceinline__ void xcd_barrier_complete(unsigned* bar, unsigned x, unsigned& nloc, unsigned& nx) {
    const unsigned G = gridDim.x * gridDim.y * gridDim.z;
    unsigned sum, cnt, mine, sp = 0u;
    for (;;) {
        sum = 0u; cnt = 0u; mine = 0u;
#pragma unroll
        for (unsigned j = 0; j < 16; ++j) { const unsigned c = xb_ld(&bar[XB_XCNT(j)]); sum += c; cnt += (c > 0u) ? 1u : 0u; mine = (j == x) ? c : mine; }
        if (sum == G) break;
        __builtin_amdgcn_s_sleep(1);
        if ((++sp & 255u) == 0u) { if (xb_ld(&bar[XB_TMO])) break; if (sp > XB_SPIN_CAP) { atomicAdd(&bar[XB_TMO], 1u); break; } }
    }
    nloc = mine > 0u ? mine : 1u; nx = cnt > 0u ? cnt : 1u;
}

__device__ __forceinline__ void xcd_barrier(const XcdBarrier& b) {
    asm volatile("s_waitcnt vmcnt(0)" ::: "memory");
    __syncthreads();
    if (threadIdx.x == 0) {
        unsigned* bar = b.bar;
        __builtin_amdgcn_s_waitcnt(0);
        unsigned nloc = b.st[0], nx = b.st[1];
        if (nloc == 0u) { xcd_barrier_complete(bar, b.x, nloc, nx); b.st[0] = nloc; b.st[1] = nx; }
        const unsigned old = xb_add(&bar[XB_XSUB(b.x)], 1u);
        const unsigned gen = old / nloc;
        if (old + 1u == (gen + 1u) * nloc) {
            __builtin_amdgcn_fence(__ATOMIC_RELEASE, "agent");
            asm volatile("s_waitcnt vmcnt(0)" ::: "memory");
            const unsigned og = xb_add(&bar[XB_TOP], 1u);
            const unsigned tg = og / nx;
            if (og + 1u == (tg + 1u) * nx) xb_add(&bar[XB_TOPGEN], 1u);
            else XB_SPIN(xb_ld(&bar[XB_TOPGEN]) == tg, bar);
            __builtin_amdgcn_fence(__ATOMIC_ACQUIRE, "agent");
            xb_add(&bar[XB_XGEN(b.x)], 1u);
            asm volatile("s_waitcnt vmcnt(0)" ::: "memory");
        } else {
            XB_SPIN(xb_ld(&bar[XB_XGEN(b.x)]) == gen, bar);
            __builtin_amdgcn_fence(__ATOMIC_ACQUIRE, "agent");
            asm volatile("s_waitcnt vmcnt(0)" ::: "memory");
        }
    }
    __syncthreads();
}


constexpr size_t OFF_BAR = 448 * 1024;
__shared__ uint4 g_xb;
__global__ void __launch_bounds__(256, 2) fwd_megakernel(Params p) {
  cg::grid_group grid = cg::this_grid();
  const int bid = blockIdx.x, G = gridDim.x;
  const int ngt = G * 256, nw = G * 4;
#define gt (bid * 256 + opaque_tid())
#define gw (bid * 4 + (opaque_tid() >> 6))
  unsigned char* ws = p.ws;
  unsigned* bar = (unsigned*)(ws + OFF_BAR);
  if (threadIdx.x == 0) g_xb = make_uint4(0u, 0u, 0u, 0u);
  __syncthreads();
  if (p.ws == nullptr) grid.sync();
  const XcdBarrier xb = xcd_barrier_post(bar, (volatile LAS unsigned*)&g_xb);

  ada_phase(p, bid, G);
  convert_w(p.in[8], nullptr, 1552, 1024, (bf16_t*)(ws + W0_IN), 52, 0, 1552, bid, G);
  convert_w(p.in[9], nullptr, 1024, 1024, (bf16_t*)(ws + W0_OUT), 32, 0, 1024, bid, G);
  convert_w(p.in[18], nullptr, 512, 512, (bf16_t*)(ws + W0_GLU), 16, 0, 512, bid, G);
  for (int hd = 0; hd < 4; ++hd) {
    if (G == 512) {
      const int o = 416 + 12 * hd;
      if (bid >= o && bid < o + 4) convert_w(p.in[22] + hd * 16384, nullptr, 128, 128, (bf16_t*)(ws + W0_Q) + hd * 16384, 4, 0, 128, bid - o, G);
      if (bid >= o + 4 && bid < o + 8) convert_w(p.in[23] + hd * 16384, nullptr, 128, 128, (bf16_t*)(ws + W0_K) + hd * 16384, 4, 3, 128, bid - o - 4, G);
      if (bid >= o + 8 && bid < o + 12) convert_w(p.in[24] + hd * 16384, nullptr, 128, 128, (bf16_t*)(ws + W0_V) + hd * 16384, 4, 0, 128, bid - o - 8, G);
    } else {
      convert_w(p.in[22] + hd * 16384, nullptr, 128, 128, (bf16_t*)(ws + W0_Q) + hd * 16384, 4, 0, 128, bid, G);
      convert_w(p.in[23] + hd * 16384, nullptr, 128, 128, (bf16_t*)(ws + W0_K) + hd * 16384, 4, 3, 128, bid, G);
      convert_w(p.in[24] + hd * 16384, nullptr, 128, 128, (bf16_t*)(ws + W0_V) + hd * 16384, 4, 0, 128, bid, G);
    }
  }
  convert_w(p.in[31], p.in[32], 2816, 1024, (bf16_t*)(ws + W0_13), 176, 1, 2816, bid, G);
  convert_w(p.in[33], nullptr, 1024, 2816, (bf16_t*)(ws + W0_2), 32, 0, 1024, bid, G);
  rope_phase(p, gt, ngt);
  if (G == 512) { if (bid >= 384) s5_ktab_phase(p, bid - 384, 128); }
  else s5_ktab_phase(p, G - 1 - bid, G);
  xcd_barrier(xb);
  rmsnorm_mod_phase(p, 0, p.in[6], 0, 0, (bf16_t*)(ws + OFF_H), gw, nw);
  s5_build_phase(p, gt, ngt);
  xcd_barrier(xb);
  l0_win_phase(p, bid, G);
  xcd_barrier(xb);
  s5_x_phase(p, bid, G);
  ml_conv_phase(p, gt, ngt);
  ml_gate_phase(p, gw, nw);
  xcd_barrier(xb);
  s5_scan_phase(p, gt, ngt);
  ml_prefix_phase(p, G - 1 - bid, G);
  if (G == 512) { if (bid >= 128) ml_qkv_phase(p, bid - 128, 384); }
  else ml_qkv_phase(p, bid, G);
  xcd_barrier(xb);
  ml_units_phase(p, bid, G);
  if (G == 512) { if (bid >= 128) s5_y_phase(p, bid - 128, 384); } else s5_y_phase(p, G - 1 - bid, G);
  xcd_barrier(xb);
  glu_phase(p, bid, G);
  ml_finish_phase(p, gw, nw);
  xcd_barrier(xb);
  l0_wout_phase(p, bid, G);
  xcd_barrier(xb);
  rmsnorm_mod_phase(p, 1, p.in[7], 0, 3, (bf16_t*)(ws + OFF_H), gw, nw);
  xcd_barrier(xb);
  ffn1_phase(p, (const bf16_t*)(ws + OFF_H), (const bf16_t*)(ws + W0_13), (bf16_t*)(ws + OFF_HID0), 144, bid, G);
  xcd_barrier(xb);
  ffn2_phase(p, (const bf16_t*)(ws + OFF_HID0), (const bf16_t*)(ws + W0_2), 0, false, bid, G);
  xcd_barrier(xb);
  rmsnorm_mod_phase(p, 1, p.in[6] + 1024, 1, 0, (bf16_t*)(ws + L1_H), gw, nw);
  convert_w(p.in[27], nullptr, 6144, 1024, (bf16_t*)(ws + L1_WIN), 192, 2, 6144, bid, G);
  xcd_barrier(xb);
  ret_in_phase(p, bid, G);
  xcd_barrier(xb);
  ret_scores_phase(p, bid, G);
  for (size_t e = gt; e < (size_t)16384 * 2048 * 2 / 16; e += ngt) ((uint4*)(ws + L1_O))[e] = make_uint4(0, 0, 0, 0);
  xcd_barrier(xb);
  if (bid >= G - 256) ret_chain_item(p, bid - (G - 256));
  xcd_barrier(xb);
  ret_headnorm_phase(p, gw, nw);
  rmsnorm_mod_phase(p, 2, p.in[6] + 1024, 1, 0, (bf16_t*)(ws + L1_HL), gw, nw);
  convert_w(p.in[27] + 4096, nullptr, 6144, 1024, (bf16_t*)(ws + L1_WG), 64, 0, 2048, bid, G);
  convert_w(p.in[28], nullptr, 1024, 2048, (bf16_t*)(ws + L1_WOUT), 32, 0, 1024, bid, G);
  convert_w(p.in[31] + (size_t)1024 * 2816, p.in[32] + (size_t)1024 * 2816, 2816, 1024, (bf16_t*)(ws + L1_W13), 176, 1, 2816, bid, G);
  convert_w(p.in[33] + (size_t)2816 * 1024, nullptr, 1024, 2816, (bf16_t*)(ws + L1_W2), 32, 0, 1024, bid, G);
  xcd_barrier(xb);
  ret_gate_phase(p, bid, G);
  xcd_barrier(xb);
  ret_wout_phase(p, bid, G);
  xcd_barrier(xb);
  rmsnorm_mod_phase(p, 2, p.in[7] + 1024, 1, 3, (bf16_t*)(ws + L1_H2), gw, nw);
  xcd_barrier(xb);
  ffn1_phase(p, (const bf16_t*)(ws + L1_H2), (const bf16_t*)(ws + L1_W13), (bf16_t*)(ws + L1_HID), 128, bid, G);
  xcd_barrier(xb);
  ffn2_phase(p, (const bf16_t*)(ws + L1_HID), (const bf16_t*)(ws + L1_W2), 1, true, bid, G);
  xcd_barrier(xb);
  final_norm_phase(p, gw, nw);
}

#undef gt
#undef gw
extern "C" void kernel_launch(void* const* d_in, const int* in_sizes, int n_in, void* d_out, int out_size,
                              void* d_ws, size_t ws_size, hipStream_t stream) {
  static int grid_blocks = 0;
  if (!grid_blocks) {
    int dev = 0, cus = 0, per_cu = 0;
    (void)hipGetDevice(&dev);
    (void)hipDeviceGetAttribute(&cus, hipDeviceAttributeMultiprocessorCount, dev);
    (void)hipOccupancyMaxActiveBlocksPerMultiprocessor(&per_cu, fwd_megakernel, 256, 0);
    if (per_cu > 2) per_cu = 2;
    if (per_cu < 1) per_cu = 1;
    grid_blocks = cus * per_cu;
  }
  Params p{};
  for (int i = 0; i < 35; ++i) p.in[i] = (const float*)d_in[i];
  p.out = (float*)d_out;
  p.ws = (unsigned char*)d_ws;
  (void)hipMemsetAsync((unsigned char*)d_ws + OFF_BAR, 0, XCD_BAR_WORDS * sizeof(unsigned), stream);
  void* args[] = {&p};
  hipError_t e = hipLaunchCooperativeKernel((void*)fwd_megakernel, dim3(grid_blocks), dim3(256), args, 0, stream);
  if (e != hipSuccess) fprintf(stderr, "cooperative launch failed: %s (grid %d)\n", hipGetErrorString(e), grid_blocks);
}
```

```cpp
#include <hip/hip_runtime.h>
#include <hip/hip_cooperative_groups.h>
#include <cstdio>
#include <cstdint>
namespace cg = cooperative_groups;

typedef unsigned short bf16_t;
typedef short bf16x8 __attribute__((ext_vector_type(8)));
typedef float f32x16 __attribute__((ext_vector_type(16)));
typedef short short2v __attribute__((ext_vector_type(2)));

#define NT 18432
#define TB 2304
#define LDT 72
#define SM_B (2 * 128 * LDT)
#define SM_ELEMS (4 * 128 * LDT)

constexpr size_t MiB = 1u << 20;
constexpr size_t OFF_MOD = 0;
constexpr size_t OFF_ROPE = MiB / 2;
constexpr size_t OFF_CTXS = 5 * MiB / 2;
constexpr size_t OFF_W0 = 21 * MiB / 2;
constexpr size_t W0_IN = OFF_W0;
constexpr size_t W0_OUT = W0_IN + 1664 * 1024 * 2;
constexpr size_t W0_GLU = W0_OUT + 1024 * 1024 * 2;
constexpr size_t W0_Q = W0_GLU + 512 * 512 * 2;
constexpr size_t W0_K = W0_Q + 4 * 128 * 128 * 2;
constexpr size_t W0_V = W0_K + 4 * 128 * 128 * 2;
constexpr size_t W0_13 = W0_V + 4 * 128 * 128 * 2;
constexpr size_t W0_2 = W0_13 + 5632 * 1024 * 2;
constexpr size_t OFF_MISC = 67 * MiB / 2;
constexpr size_t OFF_GATES = OFF_MISC;
constexpr size_t OFF_BC = OFF_GATES + (size_t)NT * 16 * 4;
constexpr size_t OFF_AA = OFF_BC + 64 * TB * 4;
constexpr size_t OFF_PM = OFF_AA + 64 * TB * 4;
constexpr size_t OFF_BL = OFF_PM + 64 * TB * 4;
constexpr size_t OFF_AM = OFF_BL + 64 * 18 * 4 + 1024;
constexpr size_t OFF_GS = OFF_AM + 64 * 18 * 4 + 1024;
constexpr size_t OFF_MU = OFF_GS + 64 * TB * 4;
constexpr size_t OFF_MN = OFF_MU + 64 * 18 * 4 + 1024;
constexpr size_t OFF_KTAB = OFF_MISC + 7 * MiB / 2;
constexpr size_t OFF_G2 = 79 * MiB / 2;
constexpr size_t OFF_E = OFF_G2 + 8 * MiB;
constexpr size_t OFF_MM = OFF_E + 8 * MiB;
constexpr size_t OFF_UG = OFF_MM + 16 * MiB;
constexpr size_t OFF_X = OFF_UG + 18 * MiB + MiB / 4;
constexpr size_t OFF_SIN = OFF_X + 18 * MiB;
constexpr size_t OFF_H = 117 * MiB;
constexpr size_t OFF_XM = 153 * MiB;
constexpr size_t OFF_XC = 171 * MiB;
constexpr size_t OFF_HDIR = 153 * MiB;
constexpr size_t OFF_OG = 189 * MiB;
constexpr size_t OFF_GY = 207 * MiB;
constexpr size_t OFF_VT0 = 225 * MiB;
constexpr size_t OFF_SCR0 = 243 * MiB;
constexpr size_t OFF_HID0 = 153 * MiB;
constexpr size_t L1_Q = 21 * MiB / 2;
constexpr size_t L1_K = L1_Q + 32 * MiB;
constexpr size_t L1_KT = L1_K + 32 * MiB;
constexpr size_t L1_VT = L1_KT + 36 * MiB;
constexpr size_t L1_O = L1_VT + 72 * MiB;
constexpr size_t L1_P = L1_O + 64 * MiB;
constexpr size_t L1_SBF = OFF_CTXS;
constexpr size_t L1_H = L1_O;
constexpr size_t L1_WIN = L1_O + 36 * MiB;
constexpr size_t L1_HL = L1_Q;
constexpr size_t L1_WG = L1_Q + 32 * MiB;
constexpr size_t L1_WOUT = L1_WG + 4 * MiB;
constexpr size_t L1_W13 = L1_WOUT + 4 * MiB;
constexpr size_t L1_W2 = L1_W13 + 11 * MiB;
constexpr size_t L1_H2 = 67 * MiB;
constexpr size_t L1_HID = 103 * MiB;

struct Params { const float* in[35]; float* out; unsigned char* ws; };

__shared__ __attribute__((aligned(16))) bf16_t g_sm[SM_ELEMS];
__shared__ float g_sf[1280];

__device__ __forceinline__ unsigned pack2(float a, float b) { unsigned r; asm("v_cvt_pk_bf16_f32 %0, %1, %2" : "=v"(r) : "v"(a), "v"(b)); return r; }
__device__ __forceinline__ bf16_t f2bf(float f) { return (bf16_t)(pack2(f, 0.f) & 0xffffu); }
__device__ __forceinline__ float bf2f(bf16_t h) { return __uint_as_float(((unsigned)h) << 16); }

__device__ __forceinline__ float blo(unsigned u) { return __uint_as_float(u << 16); }
__device__ __forceinline__ float bhi(unsigned u) { return __uint_as_float(u & 0xffff0000u); }
__device__ __forceinline__ float silu_f(float x) { return x * __builtin_amdgcn_rcpf(1.f + __expf(-x)); }
__device__ __forceinline__ float sigmoid_f(float x) { return __builtin_amdgcn_rcpf(1.f + __expf(-x)); }
__device__ __forceinline__ float gelu_tanh(float x) {
  float z = 0.7978845608028654f * (x + 0.044715f * x * x * x);
  float th = 1.f - 2.f * __builtin_amdgcn_rcpf(1.f + __expf(2.f * z));
  return 0.5f * x * (1.f + th);
}
__device__ __forceinline__ float logsigmoid_f(float x) { return fminf(x, 0.f) - log1pf(__expf(-fabsf(x))); }
__device__ __forceinline__ void sincos_r(float x, float& s, float& c) {
  float n = rintf(x * 0.15915494309189535f);
  float r = fmaf(-n, 6.2831854820251465f, x);
  r = fmaf(-n, -1.7484556000744487e-07f, r);
  s = __sinf(r); c = __cosf(r);
}
__device__ __forceinline__ float wave_sum(float v) {
#pragma unroll
  for (int o = 32; o >= 1; o >>= 1) v += __shfl_xor(v, o);
  return v;
}
__device__ __forceinline__ float wave_max(float v) {
#pragma unroll
  for (int o = 32; o >= 1; o >>= 1) v = fmaxf(v, __shfl_xor(v, o));
  return v;
}
__device__ __forceinline__ uint4 scale8(uint4 v, const float* s) {
  uint4 r;
  r.x = pack2(blo(v.x) * s[0], bhi(v.x) * s[1]);
  r.y = pack2(blo(v.y) * s[2], bhi(v.y) * s[3]);
  r.z = pack2(blo(v.z) * s[4], bhi(v.z) * s[5]);
  r.w = pack2(blo(v.w) * s[6], bhi(v.w) * s[7]);
  return r;
}

__device__ __forceinline__ int opaque_tid() { int t = threadIdx.x; asm volatile("" : "+v"(t)); return t; }
__device__ __forceinline__ uint4 scale8r(uint4 v, float s) {
  uint4 r;
  r.x = pack2(blo(v.x) * s, bhi(v.x) * s);
  r.y = pack2(blo(v.y) * s, bhi(v.y) * s);
  r.z = pack2(blo(v.z) * s, bhi(v.z) * s);
  r.w = pack2(blo(v.w) * s, bhi(v.w) * s);
  return r;
}
#define GS_LOAD(K0)                                                          \
  ra0 = *(const uint4*)(ga + (K0));              rb0 = *(const uint4*)(gb + (K0));              \
  ra1 = *(const uint4*)(ga + 32 * lda + (K0));   rb1 = *(const uint4*)(gb + 32 * ldb + (K0));   \
  ra2 = *(const uint4*)(ga + 64 * lda + (K0));   rb2 = *(const uint4*)(gb + 64 * ldb + (K0));   \
  ra3 = *(const uint4*)(ga + 96 * lda + (K0));   rb3 = *(const uint4*)(gb + 96 * ldb + (K0));   \
  if (KMODE == 2) { kg0 = *(const float4*)(kscale + (K0) + lk); kg1 = *(const float4*)(kscale + (K0) + lk + 4); }
#define GS_STORE(DA, DB, K0)                                                 \
  if (KMODE == 2) { float e_[8] = {__expf(kg0.x - kbias), __expf(kg0.y - kbias), __expf(kg0.z - kbias), __expf(kg0.w - kbias), \
                                   __expf(kg1.x - kbias), __expf(kg1.y - kbias), __expf(kg1.z - kbias), __expf(kg1.w - kbias)}; \
    ra0 = scale8(ra0, e_); ra1 = scale8(ra1, e_); ra2 = scale8(ra2, e_); ra3 = scale8(ra3, e_); }                     \
  else if (kscale) { const float* ks_ = kscale + (K0) + lk;                                                          \
    ra0 = scale8(ra0, ks_); ra1 = scale8(ra1, ks_); ra2 = scale8(ra2, ks_); ra3 = scale8(ra3, ks_); } \
  if (rscale) { ra0 = scale8r(ra0, rscale[lr]); ra1 = scale8r(ra1, rscale[lr + 32]); ra2 = scale8r(ra2, rscale[lr + 64]); ra3 = scale8r(ra3, rscale[lr + 96]); } \
  *(uint4*)(DA) = ra0; *(uint4*)((DA) + 32 * LDT) = ra1; *(uint4*)((DA) + 64 * LDT) = ra2; *(uint4*)((DA) + 96 * LDT) = ra3; \
  *(uint4*)(DB) = rb0; *(uint4*)((DB) + 32 * LDT) = rb1; *(uint4*)((DB) + 64 * LDT) = rb2; *(uint4*)((DB) + 96 * LDT) = rb3;
template <int KMODE = 1>
__device__ __forceinline__ void gemm_seg(f32x16 (&acc)[2][2], const bf16_t* __restrict__ A, size_t lda,
                                         const bf16_t* __restrict__ Bt, size_t ldb, int K, const float* kscale,
                                         const float* rscale = nullptr, float kbias = 0.f) {
  const int tid = opaque_tid(), lane = tid & 63, w = tid >> 6, wm = w >> 1, wn = w & 1;
  const int lr = tid >> 3, lk = (tid & 7) * 8;
  const bf16_t* ga = A + (size_t)lr * lda + lk;
  const bf16_t* gb = Bt + (size_t)lr * ldb + lk;
  uint4 ra0, ra1, ra2, ra3, rb0, rb1, rb2, rb3;
  float4 kg0 = make_float4(0.f, 0.f, 0.f, 0.f), kg1 = kg0; (void)kg0; (void)kg1;
  GS_LOAD(0)
  __syncthreads();
  const int nk = K >> 6;
  bf16_t* sA = g_sm;
  bf16_t* sB = g_sm + SM_B;
  const int soff = lr * LDT + lk;
  GS_STORE(sA + soff, sB + soff, 0)
  __syncthreads();
  const int aoff = (wm * 64 + (lane & 31)) * LDT + (lane >> 5) * 8;
  const int boff = (wn * 64 + (lane & 31)) * LDT + (lane >> 5) * 8;
  for (int kt = 0; kt < nk; ++kt) {
    const int buf = kt & 1;
    const bool more = (kt + 1 < nk);
    const int k1 = (kt + 1) << 6;
    if (more) { GS_LOAD(k1) }
    __builtin_amdgcn_sched_barrier(0);
    const bf16_t* pa = sA + buf * (128 * LDT) + aoff;
    const bf16_t* pb = sB + buf * (128 * LDT) + boff;
    __builtin_amdgcn_s_setprio(1);
#pragma unroll
    for (int kk = 0; kk < 4; ++kk) {
      bf16x8 a0 = *(const bf16x8*)(pa + kk * 16);
      bf16x8 a1 = *(const bf16x8*)(pa + 32 * LDT + kk * 16);
      bf16x8 b0 = *(const bf16x8*)(pb + kk * 16);
      bf16x8 b1 = *(const bf16x8*)(pb + 32 * LDT + kk * 16);
      acc[0][0] = __builtin_amdgcn_mfma_f32_32x32x16_bf16(a0, b0, acc[0][0], 0, 0, 0);
      acc[0][1] = __builtin_amdgcn_mfma_f32_32x32x16_bf16(a0, b1, acc[0][1], 0, 0, 0);
      acc[1][0] = __builtin_amdgcn_mfma_f32_32x32x16_bf16(a1, b0, acc[1][0], 0, 0, 0);
      acc[1][1] = __builtin_amdgcn_mfma_f32_32x32x16_bf16(a1, b1, acc[1][1], 0, 0, 0);
    }
    __builtin_amdgcn_s_setprio(0);
    if (more) {
      bf16_t* dA = sA + (buf ^ 1) * (128 * LDT) + soff;
      bf16_t* dB = sB + (buf ^ 1) * (128 * LDT) + soff;
      GS_STORE(dA, dB, k1)
    }
    __syncthreads();
  }
}

#define GP_LOAD(S, K0)                                                          \
  S##a0 = *(const uint4*)(ga + (K0));              S##b0 = *(const uint4*)(gb + (K0));              \
  S##a1 = *(const uint4*)(ga + 32 * lda + (K0));   S##b1 = *(const uint4*)(gb + 32 * ldb + (K0));   \
  S##a2 = *(const uint4*)(ga + 64 * lda + (K0));   S##b2 = *(const uint4*)(gb + 64 * ldb + (K0));   \
  S##a3 = *(const uint4*)(ga + 96 * lda + (K0));   S##b3 = *(const uint4*)(gb + 96 * ldb + (K0));
#define GP_STORE(S, DA, DB, K0)                                              \
  if (kscale) { const float* ks_ = kscale + (K0) + lk; S##a0 = scale8(S##a0, ks_); S##a1 = scale8(S##a1, ks_); S##a2 = scale8(S##a2, ks_); S##a3 = scale8(S##a3, ks_); } \
  if (rscale) { S##a0 = scale8r(S##a0, rscale[lr]); S##a1 = scale8r(S##a1, rscale[lr + 32]); S##a2 = scale8r(S##a2, rscale[lr + 64]); S##a3 = scale8r(S##a3, rscale[lr + 96]); } \
  *(uint4*)(DA) = S##a0; *(uint4*)((DA) + 32 * LDT) = S##a1; *(uint4*)((DA) + 64 * LDT) = S##a2; *(uint4*)((DA) + 96 * LDT) = S##a3; \
  *(uint4*)(DB) = S##b0; *(uint4*)((DB) + 32 * LDT) = S##b1; *(uint4*)((DB) + 64 * LDT) = S##b2; *(uint4*)((DB) + 96 * LDT) = S##b3;
#define GP_COMPUTE(BUF)                                                      \
  { const bf16_t* pa = sA + (BUF) * (128 * LDT) + aoff;                      \
    const bf16_t* pb = sB + (BUF) * (128 * LDT) + boff;                      \
    __builtin_amdgcn_s_setprio(1);                                           \
    _Pragma("unroll") for (int kk = 0; kk < 4; ++kk) {                       \
      bf16x8 a0 = *(const bf16x8*)(pa + kk * 16);                            \
      bf16x8 a1 = *(const bf16x8*)(pa + 32 * LDT + kk * 16);                 \
      bf16x8 b0 = *(const bf16x8*)(pb + kk * 16);                            \
      bf16x8 b1 = *(const bf16x8*)(pb + 32 * LDT + kk * 16);                 \
      acc[0][0] = __builtin_amdgcn_mfma_f32_32x32x16_bf16(a0, b0, acc[0][0], 0, 0, 0); \
      acc[0][1] = __builtin_amdgcn_mfma_f32_32x32x16_bf16(a0, b1, acc[0][1], 0, 0, 0); \
      acc[1][0] = __builtin_amdgcn_mfma_f32_32x32x16_bf16(a1, b0, acc[1][0], 0, 0, 0); \
      acc[1][1] = __builtin_amdgcn_mfma_f32_32x32x16_bf16(a1, b1, acc[1][1], 0, 0, 0); \
    } __builtin_amdgcn_s_setprio(0); }
__device__ __forceinline__ void gemm_pf2(f32x16 (&acc)[2][2], const bf16_t* __restrict__ A, size_t lda,
                                         const bf16_t* __restrict__ Bt, size_t ldb, int K, const float* kscale,
                                         const float* rscale = nullptr) {
  const int tid = opaque_tid(), lane = tid & 63, w = tid >> 6, wm = w >> 1, wn = w & 1;
  const int lr = tid >> 3, lk = (tid & 7) * 8;
  const bf16_t* ga = A + (size_t)lr * lda + lk;
  const bf16_t* gb = Bt + (size_t)lr * ldb + lk;
  uint4 xa0, xa1, xa2, xa3, xb0, xb1, xb2, xb3, ya0, ya1, ya2, ya3, yb0, yb1, yb2, yb3;
  GP_LOAD(x, 0)
  GP_LOAD(y, 64)
  __syncthreads();
  const int nk = K >> 6;
  bf16_t* sA = g_sm;
  bf16_t* sB = g_sm + SM_B;
  const int soff = lr * LDT + lk;
  GP_STORE(x, sA + soff, sB + soff, 0)
  __syncthreads();
  const int aoff = (wm * 64 + (lane & 31)) * LDT + (lane >> 5) * 8;
  const int boff = (wn * 64 + (lane & 31)) * LDT + (lane >> 5) * 8;
  for (int kt = 0; kt < nk; kt += 2) {
    const int k2 = (kt + 2) << 6, k3 = (kt + 3) << 6;
    if (kt + 2 < nk) { GP_LOAD(x, k2) }
    __builtin_amdgcn_sched_barrier(0);
    GP_COMPUTE(0)
    GP_STORE(y, sA + 128 * LDT + soff, sB + 128 * LDT + soff, k2 - 64)
    __syncthreads();
    if (kt + 3 < nk) { GP_LOAD(y, k3) }
    __builtin_amdgcn_sched_barrier(0);
    GP_COMPUTE(1)
    if (kt + 2 < nk) { GP_STORE(x, sA + soff, sB + soff, k2) }
    __syncthreads();
  }
}

#define GM_LDA(J) ma##J = *(const uint4*)(ga + (size_t)(32 * J) * lda + k0n);
#define GM_LDB(J) mb##J = *(const uint4*)(gb + (size_t)(32 * J) * ldb + k0n);
#define GM_LOAD GM_LDA(0) GM_LDA(1) GM_LDA(2) GM_LDA(3) GM_LDA(4) GM_LDA(5) GM_LDA(6) GM_LDA(7) GM_LDB(0) GM_LDB(1) GM_LDB(2) GM_LDB(3)
#define GM_STA(J) *(uint4*)(sA + soff + 32 * J * LDT) = ma##J;
#define GM_STB(J) *(uint4*)(sB + soff + 32 * J * LDT) = mb##J;
#define GM_STORE GM_STA(0) GM_STA(1) GM_STA(2) GM_STA(3) GM_STA(4) GM_STA(5) GM_STA(6) GM_STA(7) GM_STB(0) GM_STB(1) GM_STB(2) GM_STB(3)
__device__ __forceinline__ void gemm_m256(f32x16 (&acc)[4][2], const bf16_t* __restrict__ A, size_t lda,
                                          const bf16_t* __restrict__ Bt, size_t ldb, int K) {
  const int tid = opaque_tid(), lane = tid & 63, w = tid >> 6, wm = w >> 1, wn = w & 1;
  const int lr = tid >> 3, lk = (tid & 7) * 8;
  const bf16_t* ga = A + (size_t)lr * lda + lk;
  const bf16_t* gb = Bt + (size_t)lr * ldb + lk;
  uint4 ma0, ma1, ma2, ma3, ma4, ma5, ma6, ma7, mb0, mb1, mb2, mb3;
  int k0n = 0;
  GM_LOAD
  const int nk = K >> 6;
  bf16_t* sA = g_sm;
  bf16_t* sB = g_sm + 256 * LDT;
  const int soff = lr * LDT + lk;
  const bf16_t* pa = sA + (wm * 128 + (lane & 31)) * LDT + (lane >> 5) * 8;
  const bf16_t* pb = sB + (wn * 64 + (lane & 31)) * LDT + (lane >> 5) * 8;
  for (int kt = 0; kt < nk; ++kt) {
    __syncthreads();
    GM_STORE
    if (kt + 1 < nk) { k0n = (kt + 1) << 6; GM_LOAD }
    __builtin_amdgcn_sched_barrier(0);
    __syncthreads();
    __builtin_amdgcn_s_setprio(1);
#pragma unroll
    for (int kk = 0; kk < 4; ++kk) {
      bf16x8 b0 = *(const bf16x8*)(pb + kk * 16);
      bf16x8 b1 = *(const bf16x8*)(pb + 32 * LDT + kk * 16);
#pragma unroll
      for (int i = 0; i < 4; ++i) {
        bf16x8 a = *(const bf16x8*)(pa + i * 32 * LDT + kk * 16);
        acc[i][0] = __builtin_amdgcn_mfma_f32_32x32x16_bf16(a, b0, acc[i][0], 0, 0, 0);
        acc[i][1] = __builtin_amdgcn_mfma_f32_32x32x16_bf16(a, b1, acc[i][1], 0, 0, 0);
      }
    }
    __builtin_amdgcn_s_setprio(0);
  }
  __syncthreads();
}
#define ACC4_ZERO(acc)                                  \
  _Pragma("unroll") for (int i_ = 0; i_ < 4; ++i_)      \
  _Pragma("unroll") for (int j_ = 0; j_ < 2; ++j_)      \
  _Pragma("unroll") for (int r_ = 0; r_ < 16; ++r_) acc[i_][j_][r_] = 0.f;
#define EPI4_LOOP                                       \
  _Pragma("unroll") for (int i_ = 0; i_ < 4; ++i_)      \
  _Pragma("unroll") for (int j_ = 0; j_ < 2; ++j_)      \
  _Pragma("unroll") for (int r_ = 0; r_ < 16; ++r_)
#define EPI4_ROW (wm * 128 + i_ * 32 + (r_ & 3) + 8 * (r_ >> 2) + 4 * (lane >> 5))

#define ACC_ZERO(acc)                                   \
  _Pragma("unroll") for (int i_ = 0; i_ < 2; ++i_)      \
  _Pragma("unroll") for (int j_ = 0; j_ < 2; ++j_)      \
  _Pragma("unroll") for (int r_ = 0; r_ < 16; ++r_) acc[i_][j_][r_] = 0.f;
#define EPI_LOOP                                        \
  _Pragma("unroll") for (int i_ = 0; i_ < 2; ++i_)      \
  _Pragma("unroll") for (int j_ = 0; j_ < 2; ++j_)      \
  _Pragma("unroll") for (int r_ = 0; r_ < 16; ++r_)
#define EPI_ROW (wm * 64 + i_ * 32 + (r_ & 3) + 8 * (r_ >> 2) + 4 * (lane >> 5))
#define EPI_COL (wn * 64 + j_ * 32 + (lane & 31))
#define WAVE_IDS const int tid = opaque_tid(), lane = tid & 63, w = tid >> 6, wm = w >> 1, wn = w & 1; (void)tid; (void)wm; (void)wn;

__device__ __forceinline__ void convert_w(const float* src, const float* src2, int ldsrc, int K, bf16_t* dst, int ngroups, int mode, int nsrc,
                          int bid, int G) {
  float* sm = (float*)g_sm;
  const int tid = opaque_tid();
  const int ktiles = K / 128, ntiles = ngroups * ktiles;
  for (int t = bid; t < ntiles; t += G) {
    const int gi = t / ktiles, k0 = (t % ktiles) * 128;
    const float* s = src; int scol = gi * 32; float scale = 1.f; int lim = 1 << 30;
    if (mode == 0) { lim = nsrc; }
    else if (mode == 1) { s = (gi & 1) ? src2 : src; scol = (gi >> 1) * 32; }
    else if (mode == 2) {
      const int n = gi * 32;
      if (n < 2048) {
        const int region = n >> 10, rem = n & 1023, head = rem >> 8, g8 = (rem & 255) >> 5, jj = g8 >> 1, half = g8 & 1;
        scol = region * 1024 + head * 256 + half * 128 + jj * 32;
        if (region == 0) scale = 0.0625f;
      }
    } else if (mode == 3) { scale = 0.08838834764831845f; }
    __syncthreads();
#pragma unroll
    for (int j = 0; j < 4; ++j) {
      const int e = tid + 256 * j, kk = e >> 3, c4 = (e & 7) * 4;
      float4 v = make_float4(0.f, 0.f, 0.f, 0.f);
      if (scol + c4 < lim) v = *(const float4*)(s + (size_t)(k0 + kk) * ldsrc + scol + c4);
      float* d = sm + kk * 33 + c4;
      d[0] = v.x * scale; d[1] = v.y * scale; d[2] = v.z * scale; d[3] = v.w * scale;
    }
    __syncthreads();
#pragma unroll
    for (int j = 0; j < 2; ++j) {
      const int e = tid + 256 * j, nn = e >> 4, kc = (e & 15) * 8;
      const float* r = sm + kc * 33 + nn;
      uint4 o;
      o.x = pack2(r[0], r[33]); o.y = pack2(r[66], r[99]); o.z = pack2(r[132], r[165]); o.w = pack2(r[198], r[231]);
      *(uint4*)(dst + (size_t)(gi * 32 + nn) * K + k0 + kc) = o;
    }
  }
}

__device__ __forceinline__ void ada_phase(const Params& p, int bid, int G) {
  float* sm = (float*)g_sm;
  const int tid = opaque_tid();
  float* mod = (float*)(p.ws + OFF_MOD);
  bool loaded = false;
  for (int it = bid; it < 384; it += G) {
    const int layer = it / 192, cb = it % 192;
    if (!loaded) {
      __syncthreads();
      for (int e = tid; e < 9 * 1024; e += 256) {
        const int v = e >> 10, k = e & 1023;
        const float x = v < 8 ? p.in[1][v * 1024 + k] : p.in[3][k];
        sm[e] = silu_f(x);
      }
      __syncthreads();
      loaded = true;
    }
    const int col = tid & 31, ks = tid >> 5;
    const float* wp = p.in[4] + (size_t)layer * 1024 * 6144 + cb * 32 + col + (size_t)ks * 128 * 6144;
    float a[9];
#pragma unroll
    for (int v = 0; v < 9; ++v) a[v] = 0.f;
#pragma unroll 1
    for (int k0 = 0; k0 < 128; k0 += 8) {
      float wv[8];
#pragma unroll
      for (int u = 0; u < 8; ++u) wv[u] = wp[(size_t)(k0 + u) * 6144];
#pragma unroll
      for (int u = 0; u < 8; ++u)
#pragma unroll
        for (int v = 0; v < 9; ++v) a[v] += sm[v * 1024 + ks * 128 + k0 + u] * wv[u];
    }
    float* red = sm + 9 * 1024;
    __syncthreads();
#pragma unroll
    for (int v = 0; v < 9; ++v) red[(ks * 9 + v) * 32 + col] = a[v];
    __syncthreads();
    if (tid < 32) {
      const float bias = p.in[5][layer * 6144 + cb * 32 + col];
#pragma unroll
      for (int v = 0; v < 9; ++v) {
        float sacc = bias;
#pragma unroll
        for (int q = 0; q < 8; ++q) sacc += red[(q * 9 + v) * 32 + col];
        mod[((size_t)layer * 9 + v) * 6144 + cb * 32 + col] = sacc;
      }
    }
    __syncthreads();
  }
}

__device__ __forceinline__ void rope_phase(const Params& p, int gt, int ngt) {
  float* rc = (float*)(p.ws + OFF_ROPE);
  float* rs = rc + 2048 * 128;
  for (int idx = gt; idx < 2048 * 128; idx += ngt) {
    const int pos = idx >> 7, i = idx & 127;
    const int fr = i & 63;
    const float coord = (i < 64) ? (float)(pos >> 6) : (float)(pos & 63);
    const float inv = exp2f(-(float)fr * (13.287712379549449f / 64.f));
    float s, c; sincos_r(coord * inv, s, c);
    rc[idx] = c; rs[idx] = s;
  }
}

__device__ __forceinline__ void s5_apow(const Params& p, int dir, int g, int pp, float e, float& pr, float& pi) {
  const float are = p.in[10][(dir * 32 + g) * 64 + pp], aim = p.in[11][(dir * 32 + g) * 64 + pp];
  const float dt = __expf(p.in[12][dir * 32 + g]);
  const float mag = __expf(e * are * dt);
  float s, c; sincos_r(e * (aim * dt), s, c);
  pr = mag * c; pi = mag * s;
}
__device__ __forceinline__ void s5_coef(const Params& p, int dir, int g, int pp, float& cr, float& ci) {
  const float are = p.in[10][(dir * 32 + g) * 64 + pp], aim = p.in[11][(dir * 32 + g) * 64 + pp];
  float abr, abi; s5_apow(p, dir, g, pp, 1.f, abr, abi);
  const float den = are * are + aim * aim, nr = abr - 1.f;
  cr = (nr * are + abi * aim) / den;
  ci = (abi * are - nr * aim) / den;
}

__device__ __forceinline__ void s5_ktab_phase(const Params& p, int bid, int G) {
  float* ktab = (float*)(p.ws + OFF_KTAB);
  const int tid = opaque_tid();
  float* sm = (float*)g_sm;
  for (int it = bid; it < 256; it += G) {
    const int g = it >> 3, dir = (it >> 2) & 1, dg = it & 3;
    __syncthreads();
    for (int e = tid; e < 1024; e += 256) {
      sm[e] = p.in[15][(size_t)(dir * 32 + g) * 1024 + e];
      sm[1024 + e] = p.in[16][(size_t)(dir * 32 + g) * 1024 + e];
      sm[2048 + e] = p.in[13][(size_t)(dir * 32 + g) * 1024 + e];
      sm[3072 + e] = p.in[14][(size_t)(dir * 32 + g) * 1024 + e];
    }
    float cr = 0.f, ci = 0.f;
    if (tid < 64) s5_coef(p, dir, g, tid, cr, ci);
    for (int dd = 0; dd < 8; ++dd) {
      const int d = dg * 8 + dd;
      __syncthreads();
      if (tid < 64) {
        float pr, pi;
        s5_apow(p, dir, g, tid, (float)d, pr, pi);
        g_sf[tid] = pr * cr - pi * ci;
        g_sf[64 + tid] = pr * ci + pi * cr;
      }
      __syncthreads();
      const int c = tid >> 4, c2 = tid & 15;
      float acc = 0.f;
#pragma unroll 8
      for (int pp = 0; pp < 64; ++pp) {
        const float wr = g_sf[pp], wi = g_sf[64 + pp];
        const float a = sm[c * 64 + pp], b = sm[1024 + c * 64 + pp];
        const float cwr = a * wr - b * wi, cwi = a * wi + b * wr;
        acc += cwr * sm[2048 + pp * 16 + c2] - cwi * sm[3072 + pp * 16 + c2];
      }
      ktab[((size_t)(g * 2 + dir) * 32 + d) * 256 + tid] = acc;
    }
  }
}

__device__ __forceinline__ void s5_build_phase(const Params& p, int gt, int ngt) {
  bf16_t* G2 = (bf16_t*)(p.ws + OFF_G2);
  bf16_t* E = (bf16_t*)(p.ws + OFF_E);
  bf16_t* Mm = (bf16_t*)(p.ws + OFF_MM);
  const float* ktab = (const float*)(p.ws + OFF_KTAB);
  for (int idx = gt; idx < 32 * 256 * 32; idx += ngt) {
    const int j = idx & 31, n2 = (idx >> 5) & 255, g = idx >> 13;
    const int dir = n2 >> 7, ri = (n2 >> 6) & 1, pp = n2 & 63;
    const float e = dir ? (float)j : (float)(31 - j);
    float pr, pi, cr, ci;
    s5_apow(p, dir, g, pp, e, pr, pi);
    s5_coef(p, dir, g, pp, cr, ci);
    const float wr = pr * cr - pi * ci, wi = pr * ci + pi * cr;
    const float* Bre = p.in[13] + ((size_t)(dir * 32 + g) * 64 + pp) * 16;
    const float* Bim = p.in[14] + ((size_t)(dir * 32 + g) * 64 + pp) * 16;
    bf16_t* dst = G2 + ((size_t)g * 256 + n2) * 512 + j * 16;
    float vv[16];
#pragma unroll
    for (int c = 0; c < 16; ++c) vv[c] = ri ? (wr * Bim[c] + wi * Bre[c]) : (wr * Bre[c] - wi * Bim[c]);
    uint4 o0, o1;
    o0.x = pack2(vv[0], vv[1]); o0.y = pack2(vv[2], vv[3]); o0.z = pack2(vv[4], vv[5]); o0.w = pack2(vv[6], vv[7]);
    o1.x = pack2(vv[8], vv[9]); o1.y = pack2(vv[10], vv[11]); o1.z = pack2(vv[12], vv[13]); o1.w = pack2(vv[14], vv[15]);
    *(uint4*)dst = o0; *(uint4*)(dst + 8) = o1;
  }
  for (int idx = gt; idx < 32 * 32 * 2 * 64; idx += ngt) {
    const int pp = idx & 63, dir = (idx >> 6) & 1, t = (idx >> 7) & 31, g = idx >> 12;
    const float f = dir ? (float)(32 - t) : (float)(t + 1);
    float pr, pi; s5_apow(p, dir, g, pp, f, pr, pi);
    const float* Cre = p.in[15] + (size_t)(dir * 32 + g) * 16 * 64 + pp;
    const float* Cim = p.in[16] + (size_t)(dir * 32 + g) * 16 * 64 + pp;
#pragma unroll
    for (int c = 0; c < 16; ++c) {
      const float cr = Cre[c * 64], ci = Cim[c * 64];
      bf16_t* dst = E + ((size_t)g * 512 + t * 16 + c) * 256 + dir * 128 + pp;
      dst[0] = f2bf(cr * pr - ci * pi);
      dst[64] = f2bf(-(cr * pi + ci * pr));
    }
  }
  for (int idx = gt; idx < 32 * 32 * 16 * 32; idx += ngt) {
    const int j = idx & 31, c = (idx >> 5) & 15, t = (idx >> 9) & 31, g = idx >> 14;
    bf16_t* dst = Mm + ((size_t)g * 512 + t * 16 + c) * 512 + j * 16;
    const float* kf = ktab + ((size_t)(g * 2 + 0) * 32 + (t >= j ? t - j : 0)) * 256 + c * 16;
    const float* kb = ktab + ((size_t)(g * 2 + 1) * 32 + (j >= t ? j - t : 0)) * 256 + c * 16;
    const float dsk = p.in[17][g * 16 + c];
    float vv[16];
#pragma unroll
    for (int c2 = 0; c2 < 16; ++c2) {
      float v = 0.f;
      if (j <= t) v += kf[c2];
      if (j >= t) v += kb[c2];
      if (j == t && c2 == c) v += dsk;
      vv[c2] = v;
    }
    uint4 o0, o1;
    o0.x = pack2(vv[0], vv[1]); o0.y = pack2(vv[2], vv[3]); o0.z = pack2(vv[4], vv[5]); o0.w = pack2(vv[6], vv[7]);
    o1.x = pack2(vv[8], vv[9]); o1.y = pack2(vv[10], vv[11]); o1.z = pack2(vv[12], vv[13]); o1.w = pack2(vv[14], vv[15]);
    *(uint4*)dst = o0; *(uint4*)(dst + 8) = o1;
  }
}

__device__ __forceinline__ void rmsnorm_mod_phase(const Params& p, int mode, const float* g, int layer, int shift_idx, bf16_t* h, int gw, int nw) {
  const int lane = threadIdx.x & 63;
  const float* mod = (const float*)(p.ws + OFF_MOD) + (size_t)layer * 9 * 6144;
  const float* ctxs = (const float*)(p.ws + OFF_CTXS);
  const int nrows = mode == 2 ? 16384 : NT;
  for (int r = gw; r < nrows; r += nw) {
    const float* src; int v;
    if (mode == 2) { src = p.out + (size_t)r * 1024; v = r >> 11; }
    else {
      const int b = r / TB, tt = r % TB; const bool c = tt < 256; v = c ? 8 : b;
      if (mode == 0) src = c ? p.in[2] + (size_t)(b * 256 + tt) * 1024 : p.in[0] + (size_t)(b * 2048 + tt - 256) * 1024;
      else src = c ? ctxs + (size_t)(b * 256 + tt) * 1024 : p.out + (size_t)(b * 2048 + tt - 256) * 1024;
    }
    float4 xv[4]; float ss = 0.f;
#pragma unroll
    for (int j = 0; j < 4; ++j) {
      xv[j] = *(const float4*)(src + j * 256 + lane * 4);
      ss += xv[j].x * xv[j].x + xv[j].y * xv[j].y + xv[j].z * xv[j].z + xv[j].w * xv[j].w;
    }
    ss = wave_sum(ss);
    const float rstd = rsqrtf(ss * (1.f / 1024.f) + 1e-6f);
    const float* sh = mod + (size_t)v * 6144 + shift_idx * 1024;
    const float* sc = sh + 1024;
#pragma unroll
    for (int j = 0; j < 4; ++j) {
      const int c0 = j * 256 + lane * 4;
      const float4 gg = *(const float4*)(g + c0), s4 = *(const float4*)(sh + c0), c4 = *(const float4*)(sc + c0);
      const float y0 = xv[j].x * rstd * gg.x * (1.f + c4.x) + s4.x;
      const float y1 = xv[j].y * rstd * gg.y * (1.f + c4.y) + s4.y;
      const float y2 = xv[j].z * rstd * gg.z * (1.f + c4.z) + s4.z;
      const float y3 = xv[j].w * rstd * gg.w * (1.f + c4.w) + s4.w;
      uint2 o; o.x = pack2(y0, y1); o.y = pack2(y2, y3);
      *(uint2*)(h + (size_t)r * 1024 + c0) = o;
    }
  }
}

__device__ __forceinline__ float* xs_tile(const Params& p, int mt) {
  const int b = mt / 18, cc = mt % 18;
  return cc < 2 ? (float*)(p.ws + OFF_CTXS) + (size_t)(b * 256 + cc * 128) * 1024 : p.out + (size_t)(b * 2048 + (cc - 2) * 128) * 1024;
}
__device__ __forceinline__ const float* xin_tile(const Params& p, int mt) {
  const int b = mt / 18, cc = mt % 18;
  return cc < 2 ? p.in[2] + (size_t)(b * 256 + cc * 128) * 1024 : p.in[0] + (size_t)(b * 2048 + (cc - 2) * 128) * 1024;
}

__device__ __forceinline__ void l0_win_phase(const Params& p, int bid, int G) {
  WAVE_IDS
  const bf16_t* h = (const bf16_t*)(p.ws + OFF_H);
  const bf16_t* wt = (const bf16_t*)(p.ws + W0_IN);
  bf16_t* ug = (bf16_t*)(p.ws + OFF_UG);
  bf16_t* xm = (bf16_t*)(p.ws + OFF_XM);
  bf16_t* og = (bf16_t*)(p.ws + OFF_OG);
  float* gates = (float*)(p.ws + OFF_GATES);
  for (int t = bid; t < 144 * 13; t += G) {
    const int mt = t / 13, nt = t % 13;
    f32x16 acc[2][2]; ACC_ZERO(acc)
    gemm_pf2(acc, h + (size_t)mt * 128 * 1024, 1024, wt + (size_t)nt * 128 * 1024, 1024, 1024, nullptr);
    EPI_LOOP {
      const int R = mt * 128 + EPI_ROW, col = nt * 128 + EPI_COL;
      const float v = acc[i_][j_][r_];
      if (col < 512) ug[((size_t)(col >> 4) * NT + R) * 16 + (col & 15)] = f2bf(v);
      else if (col < 1024) xm[(size_t)R * 512 + col - 512] = f2bf(v);
      else if (col < 1536) og[(size_t)R * 512 + col - 1024] = f2bf(v);
      else if (col < 1552) gates[(size_t)R * 16 + col - 1536] = v;
    }
  }
}

#define STASH_LD 132
__device__ __forceinline__ void stash_acc(f32x16 (&acc)[2][2]) {
  WAVE_IDS
  float* sf = (float*)g_sm;
  EPI_LOOP { sf[EPI_ROW * STASH_LD + EPI_COL] = acc[i_][j_][r_]; }
  __syncthreads();
}
__device__ __forceinline__ void s5_x_phase(const Params& p, int bid, int G) {
  WAVE_IDS
  const bf16_t* ug = (const bf16_t*)(p.ws + OFF_UG);
  const bf16_t* G2 = (const bf16_t*)(p.ws + OFF_G2);
  float* X = (float*)(p.ws + OFF_X);
  for (int t = bid; t < 320; t += G) {
    const int g = t / 10, mt = (t % 10) >> 1, nt = t & 1;
    f32x16 acc[2][2]; ACC_ZERO(acc)
    gemm_pf2(acc, ug + (size_t)g * NT * 16 + (size_t)mt * 128 * 512, 512, G2 + ((size_t)g * 256 + nt * 128) * 512, 512, 512, nullptr);
    EPI_LOOP {
      const int rr = mt * 128 + EPI_ROW;
      if (rr < 576) X[((size_t)g * 576 + rr) * 256 + nt * 128 + EPI_COL] = acc[i_][j_][r_];
    }
  }
}

__device__ __forceinline__ void s5_scan_phase(const Params& p, int gt, int ngt) {
  const float* X = (const float*)(p.ws + OFF_X);
  bf16_t* Sin = (bf16_t*)(p.ws + OFF_SIN);
  for (int idx = gt; idx < 8 * 32 * 2 * 64; idx += ngt) {
    const int pp = idx & 63, dir = (idx >> 6) & 1, g = (idx >> 7) & 31, b = idx >> 12;
    float ar, ai; s5_apow(p, dir, g, pp, 32.f, ar, ai);
    float sr = 0.f, si = 0.f;
    const size_t gb = ((size_t)g * 576 + b * 72) * 256 + dir * 128 + pp;
#pragma unroll 1
    for (int s0 = 0; s0 < 72; s0 += 8) {
      float xr[8], xi[8];
#pragma unroll
      for (int u = 0; u < 8; ++u) {
        const int st = s0 + u, n = dir ? (st < 8 ? 7 - st : 79 - st) : st;
        xr[u] = X[gb + (size_t)n * 256]; xi[u] = X[gb + (size_t)n * 256 + 64];
      }
#pragma unroll
      for (int u = 0; u < 8; ++u) {
        const int st = s0 + u, n = dir ? (st < 8 ? 7 - st : 79 - st) : st;
        Sin[gb + (size_t)n * 256] = f2bf(sr); Sin[gb + (size_t)n * 256 + 64] = f2bf(si);
        const float nr = ar * sr - ai * si + xr[u], ni = ar * si + ai * sr + xi[u];
        sr = nr; si = ni;
      }
    }
  }
}

__device__ __forceinline__ void s5_y_phase(const Params& p, int bid, int G) {
  WAVE_IDS
  const bf16_t* ug = (const bf16_t*)(p.ws + OFF_UG);
  const bf16_t* Mm = (const bf16_t*)(p.ws + OFF_MM);
  const bf16_t* Sin = (const bf16_t*)(p.ws + OFF_SIN);
  const bf16_t* E = (const bf16_t*)(p.ws + OFF_E);
  bf16_t* gy = (bf16_t*)(p.ws + OFF_GY);
  for (int t = bid; t < 640; t += G) {
    const int g = t / 20, mt = (t % 20) >> 2, nt = t & 3;
    f32x16 acc[2][2]; ACC_ZERO(acc)
    gemm_pf2(acc, ug + (size_t)g * NT * 16 + (size_t)mt * 128 * 512, 512, Mm + ((size_t)g * 512 + nt * 128) * 512, 512, 512, nullptr);
    gemm_pf2(acc, Sin + ((size_t)g * 576 + mt * 128) * 256, 256, E + ((size_t)g * 512 + nt * 128) * 256, 256, 256, nullptr);
    stash_acc(acc);
    {
      const float* sfr = (const float*)g_sm;
#pragma unroll
      for (int it = 0; it < 4; ++it) {
        const int e = it * 256 + tid, row = e >> 3, t8 = e & 7;
        const int rr = mt * 128 + row;
        if (rr < 576) {
          const float* sp = sfr + row * STASH_LD + t8 * 16;
          const float4 a0 = *(const float4*)sp, a1 = *(const float4*)(sp + 4), a2 = *(const float4*)(sp + 8), a3 = *(const float4*)(sp + 12);
          uint4 o0, o1;
          o0.x = pack2(gelu_tanh(a0.x), gelu_tanh(a0.y)); o0.y = pack2(gelu_tanh(a0.z), gelu_tanh(a0.w));
          o0.z = pack2(gelu_tanh(a1.x), gelu_tanh(a1.y)); o0.w = pack2(gelu_tanh(a1.z), gelu_tanh(a1.w));
          o1.x = pack2(gelu_tanh(a2.x), gelu_tanh(a2.y)); o1.y = pack2(gelu_tanh(a2.z), gelu_tanh(a2.w));
          o1.z = pack2(gelu_tanh(a3.x), gelu_tanh(a3.y)); o1.w = pack2(gelu_tanh(a3.z), gelu_tanh(a3.w));
          bf16_t* dst = gy + ((size_t)rr * 32 + nt * 8 + t8) * 512 + g * 16;
          *(uint4*)dst = o0; *(uint4*)(dst + 8) = o1;
        }
      }
    }
    __syncthreads();
  }
}

__device__ __forceinline__ void glu_phase(const Params& p, int bid, int G) {
  WAVE_IDS
  const bf16_t* gy = (const bf16_t*)(p.ws + OFF_GY);
  const bf16_t* wt = (const bf16_t*)(p.ws + W0_GLU);
  bf16_t* mix = (bf16_t*)(p.ws + OFF_H);
  const float* gb = p.in[19];
  for (int t = bid; t < 144 * 4; t += G) {
    const int mt = t >> 2, nt = t & 3;
    f32x16 acc[2][2]; ACC_ZERO(acc)
    gemm_pf2(acc, gy + (size_t)mt * 128 * 512, 512, wt + (size_t)nt * 128 * 512, 512, 512, nullptr);
    EPI_LOOP {
      const int R = mt * 128 + EPI_ROW, col = nt * 128 + EPI_COL;
      const float a = bf2f(gy[(size_t)R * 512 + col]);
      mix[(size_t)R * 1024 + col] = f2bf(a * sigmoid_f(acc[i_][j_][r_] + gb[col]));
    }
  }
}

__device__ __forceinline__ void ml_conv_phase(const Params& p, int gt, int ngt) {
  const bf16_t* xm = (const bf16_t*)(p.ws + OFF_XM);
  bf16_t* xc = (bf16_t*)(p.ws + OFF_XC);
  const float* cw = p.in[20]; const float* cb = p.in[21];
  for (int idx = gt; idx < NT * 64; idx += ngt) {
    const int R = idx >> 6, c0 = (idx & 63) * 8;
    const int tt = R % TB;
    const int lo = tt < 256 ? 0 : 256, hi = tt < 256 ? 256 : TB;
    float a[8];
#pragma unroll
    for (int e = 0; e < 8; ++e) a[e] = cb[c0 + e];
#pragma unroll
    for (int k = 0; k < 5; ++k) {
      const int t2 = tt + k - 2;
      if (t2 >= lo && t2 < hi) {
        const uint4 v = *(const uint4*)(xm + (size_t)(R + k - 2) * 512 + c0);
        const float* wk = cw + k * 512 + c0;
        a[0] += wk[0] * blo(v.x); a[1] += wk[1] * bhi(v.x);
        a[2] += wk[2] * blo(v.y); a[3] += wk[3] * bhi(v.y);
        a[4] += wk[4] * blo(v.z); a[5] += wk[5] * bhi(v.z);
        a[6] += wk[6] * blo(v.w); a[7] += wk[7] * bhi(v.w);
      }
    }
    uint4 o;
    o.x = pack2(silu_f(a[0]), silu_f(a[1])); o.y = pack2(silu_f(a[2]), silu_f(a[3]));
    o.z = pack2(silu_f(a[4]), silu_f(a[5])); o.w = pack2(silu_f(a[6]), silu_f(a[7]));
    *(uint4*)(xc + (size_t)R * 512 + c0) = o;
  }
}

__device__ __forceinline__ void ml_gate_phase(const Params& p, int gw, int nw) {
  const int lane = threadIdx.x & 63;
  const float* gates = (const float*)(p.ws + OFF_GATES);
  const float* gb = p.in[25];
  float* Bc = (float*)(p.ws + OFF_BC); float* Aa = (float*)(p.ws + OFF_AA); float* PM = (float*)(p.ws + OFF_PM);
  float* BL = (float*)(p.ws + OFF_BL); float* AM = (float*)(p.ws + OFF_AM);
  for (int it = gw; it < 64 * 18; it += nw) {
    const int cc = it % 18, chain = it / 18, dir = chain & 1, hh = (chain >> 1) & 3, b = chain >> 3;
    const int p0 = 2 * lane, p1 = 2 * lane + 1;
    const int t0 = dir ? 127 - p0 : p0, t1 = dir ? 127 - p1 : p1;
    const size_t R0 = (size_t)b * TB + cc * 128 + t0, R1 = (size_t)b * TB + cc * 128 + t1;
    const float i0 = gates[R0 * 16 + dir * 8 + hh] + gb[dir * 8 + hh], i1 = gates[R1 * 16 + dir * 8 + hh] + gb[dir * 8 + hh];
    const float f0 = gates[R0 * 16 + dir * 8 + 4 + hh] + gb[dir * 8 + 4 + hh], f1 = gates[R1 * 16 + dir * 8 + 4 + hh] + gb[dir * 8 + 4 + hh];
    const float l0 = logsigmoid_f(f0), l1 = logsigmoid_f(f1);
    float incl = l0 + l1;
#pragma unroll
    for (int o = 1; o < 64; o <<= 1) { const float n = __shfl_up(incl, o); if (lane >= o) incl += n; }
    const float excl = incl - (l0 + l1);
    const float b0 = excl + l0, b1 = excl + l0 + l1;
    const float a0 = i0 - b0, a1 = i1 - b1;
    float pm = fmaxf(a0, a1);
#pragma unroll
    for (int o = 1; o < 64; o <<= 1) { const float n = __shfl_up(pm, o); if (lane >= o) pm = fmaxf(pm, n); }
    float pe = __shfl_up(pm, 1); if (lane == 0) pe = -3.0e38f;
    const float pm0 = fmaxf(pe, a0), pm1 = pm;
    const size_t o0 = (size_t)chain * TB + cc * 128 + t0, o1 = (size_t)chain * TB + cc * 128 + t1;
    Bc[o0] = b0; Bc[o1] = b1; Aa[o0] = a0; Aa[o1] = a1; PM[o0] = pm0; PM[o1] = pm1;
    const float blast = __shfl(b1, 63), amax = __shfl(pm, 63);
    if (lane == 0) { BL[chain * 18 + cc] = blast; AM[chain * 18 + cc] = amax; }
  }
}

__device__ __forceinline__ void ml_qkv_phase(const Params& p, int bid, int G) {
  WAVE_IDS
  const bf16_t* xm = (const bf16_t*)(p.ws + OFF_XM);
  const bf16_t* xc = (const bf16_t*)(p.ws + OFF_XC);
  bf16_t* q = (bf16_t*)p.out;
  bf16_t* k = q + (size_t)NT * 512;
  bf16_t* kT = k + (size_t)NT * 512;
  bf16_t* vT = (bf16_t*)(p.ws + OFF_VT0);
  for (int t = bid; t < 144 * 12; t += G) {
    const int mt = t / 12, sub = t % 12, which = sub >> 2, hd = sub & 3;
    const bf16_t* A = (which < 2 ? xc : xm) + (size_t)mt * 128 * 512 + hd * 128;
    const bf16_t* Bt = (const bf16_t*)(p.ws + (which == 0 ? W0_Q : which == 1 ? W0_K : W0_V)) + (size_t)hd * 16384;
    f32x16 acc[2][2]; ACC_ZERO(acc)
    gemm_seg(acc, A, 512, Bt, 128, 128, nullptr);
    const int b = mt / 18, tt0 = (mt % 18) * 128;
    if (which < 2) {
      bf16_t* dst = which == 0 ? q : k;
      EPI_LOOP { dst[(size_t)(mt * 128 + EPI_ROW) * 512 + hd * 128 + EPI_COL] = f2bf(acc[i_][j_][r_]); }
    }
    if (which >= 1) {
      bf16_t* dT = (which == 1 ? kT : vT) + (size_t)(b * 4 + hd) * 128 * TB;
      {
        float* sfw = (float*)g_sm;
        EPI_LOOP { sfw[EPI_ROW * 129 + EPI_COL] = acc[i_][j_][r_]; }
        __syncthreads();
#pragma unroll 2
        for (int it = 0; it < 8; ++it) {
          const int e = it * 256 + tid, r8 = e & 15, col = e >> 4;
          const float* sp = sfw + (r8 * 8) * 129 + col;
          uint4 o;
          o.x = pack2(sp[0], sp[129]); o.y = pack2(sp[258], sp[387]); o.z = pack2(sp[516], sp[645]); o.w = pack2(sp[774], sp[903]);
          *(uint4*)(dT + (size_t)col * TB + tt0 + r8 * 8) = o;
        }
        __syncthreads();
      }
    }
  }
}

#define P_LD 136
__device__ __forceinline__ void gemm_alds(f32x16 (&acc)[2][2], const bf16_t* __restrict__ Bt, size_t ldb) {
  const int tid = opaque_tid(), lane = tid & 63, w = tid >> 6, wm = w >> 1, wn = w & 1;
  const int lr = tid >> 3, lk = (tid & 7) * 8;
  const bf16_t* gb = Bt + (size_t)lr * ldb + lk;
  uint4 rb0 = *(const uint4*)(gb), rb1 = *(const uint4*)(gb + 32 * ldb), rb2 = *(const uint4*)(gb + 64 * ldb), rb3 = *(const uint4*)(gb + 96 * ldb);
  bf16_t* sB = g_sm + 128 * P_LD;
  const int soff = lr * LDT + lk;
  *(uint4*)(sB + soff) = rb0; *(uint4*)(sB + soff + 32 * LDT) = rb1; *(uint4*)(sB + soff + 64 * LDT) = rb2; *(uint4*)(sB + soff + 96 * LDT) = rb3;
  rb0 = *(const uint4*)(gb + 64); rb1 = *(const uint4*)(gb + 32 * ldb + 64); rb2 = *(const uint4*)(gb + 64 * ldb + 64); rb3 = *(const uint4*)(gb + 96 * ldb + 64);
  __syncthreads();
  const int aoff = (wm * 64 + (lane & 31)) * P_LD + (lane >> 5) * 8;
  const int boff = (wn * 64 + (lane & 31)) * LDT + (lane >> 5) * 8;
#pragma unroll
  for (int kt = 0; kt < 2; ++kt) {
    const bf16_t* pa = g_sm + aoff + kt * 64;
    const bf16_t* pb = sB + kt * (128 * LDT) + boff;
#pragma unroll
    for (int kk = 0; kk < 4; ++kk) {
      bf16x8 a0 = *(const bf16x8*)(pa + kk * 16);
      bf16x8 a1 = *(const bf16x8*)(pa + 32 * P_LD + kk * 16);
      bf16x8 b0 = *(const bf16x8*)(pb + kk * 16);
      bf16x8 b1 = *(const bf16x8*)(pb + 32 * LDT + kk * 16);
      acc[0][0] = __builtin_amdgcn_mfma_f32_32x32x16_bf16(a0, b0, acc[0][0], 0, 0, 0);
      acc[0][1] = __builtin_amdgcn_mfma_f32_32x32x16_bf16(a0, b1, acc[0][1], 0, 0, 0);
      acc[1][0] = __builtin_amdgcn_mfma_f32_32x32x16_bf16(a1, b0, acc[1][0], 0, 0, 0);
      acc[1][1] = __builtin_amdgcn_mfma_f32_32x32x16_bf16(a1, b1, acc[1][1], 0, 0, 0);
    }
    if (kt == 0) {
      bf16_t* dB = sB + 128 * LDT + soff;
      *(uint4*)(dB) = rb0; *(uint4*)(dB + 32 * LDT) = rb1; *(uint4*)(dB + 64 * LDT) = rb2; *(uint4*)(dB + 96 * LDT) = rb3;
    }
    __syncthreads();
  }
}
__device__ __forceinline__ void scores_to_lds(f32x16 (&acc)[2][2], int dir, bool strict) {
  WAVE_IDS
  const float* s_alpha = g_sf; const float* s_beta = g_sf + 128;
  EPI_LOOP {
    const int t = EPI_ROW, s = EPI_COL;
    const int pt = dir ? 127 - t : t, ps = dir ? 127 - s : s;
    const bool ok = strict ? (ps < pt) : (ps <= pt);
    const float v = ok ? acc[i_][j_][r_] * __expf(s_alpha[s] - s_beta[t]) : 0.f;
    g_sm[t * P_LD + s] = f2bf(v);
  }
  __syncthreads();
}
__device__ __forceinline__ void atomic_add_bf16x2(unsigned* addr, float a, float b) {
  unsigned old = __atomic_load_n(addr, __ATOMIC_RELAXED);
  while (true) {
    const unsigned nw = pack2(blo(old) + a, bhi(old) + b);
    const unsigned prev = atomicCAS(addr, old, nw);
    if (prev == old) break;
    old = prev;
  }
}

__device__ __forceinline__ void ret_scores_phase(const Params& p, int bid, int G) {
  WAVE_IDS
  const bf16_t* q = (const bf16_t*)(p.ws + L1_Q);
  bf16_t* k = (bf16_t*)(p.ws + L1_K);
  for (int t = bid; t < 512; t += G) {
    const int hd = t & 3, c = (t >> 2) & 15, b = t >> 6;
    const size_t base = ((size_t)b * 2048 + c * 128) * 1024 + hd * 256;
    const float lgf = p.in[29][hd], lgb = p.in[29][4 + hd];
    f32x16 acc[2][2]; ACC_ZERO(acc)
    gemm_pf2(acc, q + base, 1024, k + base, 1024, 256, nullptr);
    stash_acc(acc);
    {
      const float* sf = (const float*)g_sm;
#pragma unroll 2
      for (int e = tid; e < 4096; e += 256) {
        const int tq = e >> 5, s0 = (e & 31) * 4;
        const float4 v = *(const float4*)(sf + tq * STASH_LD + s0);
        float vv[4] = {v.x, v.y, v.z, v.w}, pf[4], pb[4];
#pragma unroll
        for (int u = 0; u < 4; ++u) {
          const int sk = s0 + u; const float d = (float)(tq - sk);
          pf[u] = (sk <= tq) ? vv[u] * __expf(lgf * d) : 0.f;
          pb[u] = (sk > tq) ? vv[u] * __expf(-lgb * d) : 0.f;
        }
        bf16_t* dst = k + base + (size_t)tq * 1024 + s0;
        uint2 wf, wb; wf.x = pack2(pf[0], pf[1]); wf.y = pack2(pf[2], pf[3]); wb.x = pack2(pb[0], pb[1]); wb.y = pack2(pb[2], pb[3]);
        *(uint2*)dst = wf; *(uint2*)(dst + 128) = wb;
      }
    }
    __syncthreads();
  }
}

__device__ __forceinline__ void ret_chain_item(const Params& p, int item) {
  const int tid = opaque_tid();
  const int dir = item & 1, vs = (item >> 1) & 3, hd = (item >> 3) & 3, b = item >> 5;
  const bf16_t* qb = (const bf16_t*)(p.ws + L1_Q) + (size_t)b * 2048 * 1024 + hd * 256;
  const bf16_t* kb = (const bf16_t*)(p.ws + L1_K) + (size_t)b * 2048 * 1024 + hd * 256;
  const bf16_t* kT = (const bf16_t*)(p.ws + L1_KT) + (size_t)(b * 4 + hd) * 256 * TB;
  const bf16_t* vT = (const bf16_t*)(p.ws + L1_VT) + ((size_t)(b * 4 + hd) * 512 + vs * 128) * TB;
  bf16_t* Sbf = (bf16_t*)(p.ws + (item < 152 ? L1_P + (size_t)item * 65536 : OFF_ROPE + (size_t)(item - 152) * 65536));
  bf16_t* o = (bf16_t*)(p.ws + L1_O) + (size_t)b * 2048 * 2048 + hd * 512 + vs * 128;
  const float lg = p.in[29][dir * 4 + hd];
  const bool strict = dir == 1;
  const float* sf = (const float*)g_sm;
  float* s_alpha = g_sf, *s_beta = g_sf + 128, *s_rse = g_sf + 256, *s_wexp = g_sf + 384;
  __syncthreads();
  for (int e = tid; e < 128 * 256 / 8; e += 256) *(uint4*)(Sbf + e * 8) = make_uint4(0, 0, 0, 0);
  if (tid < 128) {
    const float pp = dir ? (float)(127 - tid) : (float)tid;
    s_alpha[tid] = -lg * pp; s_beta[tid] = -lg * pp; s_rse[tid] = __expf(lg * (pp + 1.f)); s_wexp[tid] = __expf(lg * (127.f - pp));
  }
  const float dec = __expf(128.f * lg);
  __threadfence_block();
  __syncthreads();
#pragma unroll 1
  for (int st = 0; st < 18; ++st) {
    const int cc = dir ? (st == 0 ? 1 : st == 1 ? 0 : 19 - st) : st;
    const int tt0 = cc * 128;
    if (cc >= 2) {
      const bf16_t* qc = qb + (size_t)(tt0 - 256) * 1024;
      const bf16_t* kc = kb + (size_t)(tt0 - 256) * 1024;
      {
        f32x16 acc[2][2]; ACC_ZERO(acc)
        gemm_seg(acc, kc + dir * 128, 1024, vT + tt0, TB, 128, nullptr);
        gemm_seg(acc, qc, 1024, Sbf, 256, 256, nullptr, s_rse);
        stash_acc(acc);
      }
#pragma unroll 4
      for (int it = 0; it < 32; ++it) {
        const int wd = it * 256 + tid, t = wd >> 6, wc = wd & 63;
        const float2 v = *(const float2*)(sf + t * STASH_LD + 2 * wc);
        short2v pk; pk[0] = (short)f2bf(v.x); pk[1] = (short)f2bf(v.y);
        __builtin_amdgcn_global_atomic_fadd_v2bf16((__attribute__((address_space(1))) short2v*)(o + (size_t)(tt0 - 256 + t) * 2048 + 2 * wc), pk);
      }
    }
#pragma unroll 1
    for (int nt = 0; nt < 2; ++nt) {
      {
        f32x16 acc[2][2]; ACC_ZERO(acc)
        gemm_seg(acc, vT + tt0, TB, kT + (size_t)nt * 128 * TB + tt0, TB, 128, s_wexp);
        stash_acc(acc);
      }
#pragma unroll 8
      for (int e = tid; e < 4096; e += 256) {
        const int v = e >> 5, k0 = nt * 128 + (e & 31) * 4;
        const float4 a = *(const float4*)(sf + v * STASH_LD + (e & 31) * 4);
        const uint2 old = *(const uint2*)(Sbf + v * 256 + k0);
        uint2 w2;
        w2.x = pack2(dec * blo(old.x) + a.x, dec * bhi(old.x) + a.y);
        w2.y = pack2(dec * blo(old.y) + a.z, dec * bhi(old.y) + a.w);
        *(uint2*)(Sbf + v * 256 + k0) = w2;
      }
    }
    __threadfence_block();
    __syncthreads();
  }
}

__device__ __forceinline__ void ml_prefix_phase(const Params& p, int bid, int G) {
  const int tid = opaque_tid();
  const float* Aa = (const float*)(p.ws + OFF_AA);
  const float* BL = (const float*)(p.ws + OFF_BL); const float* AM = (const float*)(p.ws + OFF_AM);
  float* Gs = (float*)(p.ws + OFF_GS); float* MU = (float*)(p.ws + OFF_MU); float* MN = (float*)(p.ws + OFF_MN);
  for (int chain = bid; chain < 64; chain += G) {
    const int dir = chain & 1;
    __syncthreads();
    if (tid == 0) {
      float F = 0.f, mu = 0.f;
      for (int st = 0; st < 18; ++st) {
        const int cc = dir ? (st == 0 ? 1 : st == 1 ? 0 : 19 - st) : st;
        g_sf[cc] = F;
        MU[chain * 18 + st] = mu; MN[chain * 18 + st] = mu + F;
        mu = fmaxf(mu, AM[chain * 18 + cc] - F);
        F += BL[chain * 18 + cc];
      }
    }
    __syncthreads();
    for (int tt = tid; tt < TB; tt += 256) Gs[(size_t)chain * TB + tt] = Aa[(size_t)chain * TB + tt] - g_sf[tt >> 7];
  }
}

__device__ __forceinline__ void ml_unit(const Params& p, int chain, int st, bf16_t* Sbf) {
  const int tid = opaque_tid();
  const int dir = chain & 1, hd = (chain >> 1) & 3, b = chain >> 3;
  const int cc = dir ? (st == 0 ? 1 : st == 1 ? 0 : 19 - st) : st;
  const int tt0 = cc * 128;
  const bf16_t* q = (const bf16_t*)p.out;
  const bf16_t* k = q + (size_t)NT * 512;
  const bf16_t* kT = k + (size_t)NT * 512 + (size_t)(b * 4 + hd) * 128 * TB;
  const bf16_t* vT = (const bf16_t*)(p.ws + OFF_VT0) + (size_t)(b * 4 + hd) * 128 * TB;
  const bf16_t* qc = q + ((size_t)b * TB + tt0) * 512 + hd * 128;
  const bf16_t* kc = k + ((size_t)b * TB + tt0) * 512 + hd * 128;
  const float* Gs = (const float*)(p.ws + OFF_GS) + (size_t)chain * TB;
  const float mu = ((const float*)(p.ws + OFF_MU))[chain * 18 + st];
  const float m_in = ((const float*)(p.ws + OFF_MN))[chain * 18 + st];
  const float* Bc = (const float*)(p.ws + OFF_BC) + (size_t)chain * TB;
  const float* Aa = (const float*)(p.ws + OFF_AA) + (size_t)chain * TB;
  const float* PMx = (const float*)(p.ws + OFF_PM) + (size_t)chain * TB;
  bf16_t* hout = (bf16_t*)(p.ws + OFF_HDIR) + (size_t)dir * NT * 512 + ((size_t)b * TB + tt0) * 512 + hd * 128;
  const float* sf = (const float*)g_sm;
  float* s_alpha = g_sf, *s_beta = g_sf + 128, *s_rse = g_sf + 256, *s_den = g_sf + 512, *s_mexp = g_sf + 640, *s_n = g_sf + 768, *s_red = g_sf + 896;
  int r0 = 0, len0 = 0, r1 = 0, len1 = 0;
  if (!dir) { len0 = 128 * st; }
  else if (st == 1) { r0 = 128; len0 = 128; }
  else if (st >= 2) { r0 = 0; len0 = 256; r1 = (20 - st) * 128; len1 = TB - r1; }
  __syncthreads();
  if (st > 0) {
    {
      f32x16 acc[2][2]; ACC_ZERO(acc)
      gemm_seg<2>(acc, vT + r0, TB, kT + r0, TB, len0, Gs + r0, nullptr, mu);
      if (len1 > 0) gemm_seg<2>(acc, vT + r1, TB, kT + r1, TB, len1, Gs + r1, nullptr, mu);
      stash_acc(acc);
    }
#pragma unroll 1
    for (int e = tid; e < 4096; e += 256) {
      const int v = e >> 5, k0 = (e & 31) * 4;
      const float4 a = *(const float4*)(sf + v * STASH_LD + k0);
      uint2 w2; w2.x = pack2(a.x, a.y); w2.y = pack2(a.z, a.w);
      *(uint2*)(Sbf + v * 128 + k0) = w2;
    }
    __syncthreads();
    float* wl = (float*)g_sm;
    const int lent = len0 + len1;
    for (int i = tid; i < lent; i += 256) wl[i] = __expf(Gs[i < len0 ? r0 + i : r1 + i - len0] - mu);
    __syncthreads();
    {
      const int kk = tid & 127, half = tid >> 7, hl = lent >> 1;
      const bf16_t* kr = kT + (size_t)kk * TB;
      float s = 0.f;
#pragma unroll 2
      for (int i = half * hl; i < (half + 1) * hl; i += 8) {
        const uint4 kv = *(const uint4*)(kr + (i < len0 ? r0 + i : r1 + i - len0));
        const float* ww = wl + i;
        s += ww[0] * blo(kv.x) + ww[1] * bhi(kv.x) + ww[2] * blo(kv.y) + ww[3] * bhi(kv.y) + ww[4] * blo(kv.z) + ww[5] * bhi(kv.z) + ww[6] * blo(kv.w) + ww[7] * bhi(kv.w);
      }
      s_red[tid] = s;
    }
    __syncthreads();
    if (tid < 128) s_n[tid] = s_red[tid] + s_red[tid + 128];
  } else {
    if (tid < 128) s_n[tid] = 0.f;
  }
  if (tid < 128) {
    const int t = tid;
    const float a = Aa[tt0 + t], be = fmaxf(m_in, PMx[tt0 + t]);
    s_alpha[t] = a; s_beta[t] = be; s_rse[t] = __expf(m_in - be);
    s_mexp[t] = __expf(-(Bc[tt0 + t] + be));
  }
  __threadfence_block();
  __syncthreads();
  {
    f32x16 acc[2][2]; ACC_ZERO(acc)
    gemm_seg(acc, qc, 512, kc, 512, 128, nullptr);
    scores_to_lds(acc, dir, false);
  }
  if (tid < 128) {
    const int t = tid; float sum = 0.f, qn = 0.f;
    const uint4* pr = (const uint4*)(g_sm + t * P_LD);
    const uint4* qr = (const uint4*)(qc + (size_t)t * 512);
#pragma unroll 2
    for (int e = 0; e < 16; ++e) {
      const uint4 pv = pr[e], qv = qr[e];
      sum += blo(pv.x) + bhi(pv.x) + blo(pv.y) + bhi(pv.y) + blo(pv.z) + bhi(pv.z) + blo(pv.w) + bhi(pv.w);
      const float* nn = s_n + e * 8;
      qn += blo(qv.x) * nn[0] + bhi(qv.x) * nn[1] + blo(qv.y) * nn[2] + bhi(qv.y) * nn[3] + blo(qv.z) * nn[4] + bhi(qv.z) * nn[5] + blo(qv.w) * nn[6] + bhi(qv.w) * nn[7];
    }
    s_den[t] = sum + s_rse[t] * qn;
  }
  {
    f32x16 acc[2][2]; ACC_ZERO(acc)
    gemm_alds(acc, vT + tt0, TB);
    if (st > 0) gemm_seg(acc, qc, 512, Sbf, 128, 128, nullptr, s_rse);
    stash_acc(acc);
  }
#pragma unroll 1
  for (int e = tid; e < 4096; e += 256) {
    const int t = e >> 5, c0 = (e & 31) * 4;
    const float4 v = *(const float4*)(sf + t * STASH_LD + c0);
    const float sc = 1.f / fmaxf(fabsf(s_den[t]), s_mexp[t]);
    uint2 w2; w2.x = pack2(v.x * sc, v.y * sc); w2.y = pack2(v.z * sc, v.w * sc);
    *(uint2*)(hout + (size_t)t * 512 + c0) = w2;
  }
  __syncthreads();
}
__device__ __forceinline__ void ml_units_phase(const Params& p, int bid, int G) {
  bf16_t* Sbf = (bf16_t*)(p.ws + OFF_X) + (size_t)bid * 16384;
  if (G == 512) {
    { const int u = bid; ml_unit(p, u & 63, 17 - (u >> 6), Sbf); }
    { const int u = 1023 - bid; ml_unit(p, u & 63, 17 - (u >> 6), Sbf); }
    if (bid < 128) { const int u = 1024 + bid; ml_unit(p, u & 63, 17 - (u >> 6), Sbf); }
  } else {
    for (int u = bid; u < 1152; u += G) ml_unit(p, u & 63, 17 - (u >> 6), Sbf);
  }
}

__device__ __forceinline__ void ml_finish_phase(const Params& p, int gw, int nw) {
  const int lane = threadIdx.x & 63;
  const bf16_t* h0 = (const bf16_t*)(p.ws + OFF_HDIR);
  const bf16_t* h1 = h0 + (size_t)NT * 512;
  const bf16_t* og = (const bf16_t*)(p.ws + OFF_OG);
  bf16_t* mix = (bf16_t*)(p.ws + OFF_H);
  const float* ng = p.in[26];
  for (int it = gw; it < NT * 4; it += nw) {
    const int R = it >> 2, hd = it & 3;
    const size_t o = (size_t)R * 512 + hd * 128 + lane * 2;
    const unsigned a = *(const unsigned*)(h0 + o), bq = *(const unsigned*)(h1 + o), g2 = *(const unsigned*)(og + o);
    const float v0 = blo(a) + blo(bq), v1 = bhi(a) + bhi(bq);
    const float mu = wave_sum(v0 + v1) * (1.f / 128.f);
    const float d0 = v0 - mu, d1 = v1 - mu;
    const float var = wave_sum(d0 * d0 + d1 * d1) * (1.f / 128.f);
    const float rs = rsqrtf(var + 1e-6f);
    const float y0 = d0 * rs * ng[hd * 128 + lane * 2] * sigmoid_f(blo(g2));
    const float y1 = d1 * rs * ng[hd * 128 + lane * 2 + 1] * sigmoid_f(bhi(g2));
    *(unsigned*)(mix + (size_t)R * 1024 + 512 + hd * 128 + lane * 2) = pack2(y0, y1);
  }
}

__device__ __forceinline__ void l0_wout_phase(const Params& p, int bid, int G) {
  WAVE_IDS
  const bf16_t* mix = (const bf16_t*)(p.ws + OFF_H);
  const bf16_t* wt = (const bf16_t*)(p.ws + W0_OUT);
  const float* mod = (const float*)(p.ws + OFF_MOD);
  for (int t = bid; t < 144 * 8; t += G) {
    const int mt = t >> 3, nt = t & 7;
    f32x16 acc[2][2]; ACC_ZERO(acc)
    gemm_pf2(acc, mix + (size_t)mt * 128 * 1024, 1024, wt + (size_t)nt * 128 * 1024, 1024, 1024, nullptr);
    const int v = (mt % 18) < 2 ? 8 : mt / 18;
    const float* gate = mod + (size_t)v * 6144 + 2 * 1024;
    const float* xi = xin_tile(p, mt); float* xo = xs_tile(p, mt);
    EPI_LOOP {
      const int row = EPI_ROW, col = nt * 128 + EPI_COL;
      xo[(size_t)row * 1024 + col] = xi[(size_t)row * 1024 + col] + gate[col] * acc[i_][j_][r_];
    }
  }
}

__device__ __forceinline__ void ffn1_phase(const Params& p, const bf16_t* h, const bf16_t* w13, bf16_t* hid, int ntm, int bid, int G) {
  WAVE_IDS
  const int ntm2 = ntm >> 1;
  const int nbig = ntm2 * 44;
  const int nfull = (nbig / G) * G;
  for (int t = bid; t < nfull; t += G) {
    const int mt = t / 44, nt = t % 44;
    f32x16 acc[4][2]; ACC4_ZERO(acc)
    gemm_m256(acc, h + (size_t)mt * 256 * 1024, 1024, w13 + (size_t)nt * 128 * 1024, 1024, 1024);
#pragma unroll
    for (int i_ = 0; i_ < 4; ++i_)
#pragma unroll
      for (int r_ = 0; r_ < 16; ++r_) {
        const int row = wm * 128 + i_ * 32 + (r_ & 3) + 8 * (r_ >> 2) + 4 * (lane >> 5);
        const float gv = acc[i_][0][r_], uv = acc[i_][1][r_];
        hid[(size_t)(mt * 256 + row) * 2816 + nt * 64 + wn * 32 + (lane & 31)] = f2bf(silu_f(gv) * uv);
      }
  }
  const int nsmall = (nbig - nfull) * 2;
  for (int u = bid; u < nsmall; u += G) {
    const int tb = nfull + (u >> 1), mt = (tb / 44) * 2 + (u & 1), nt = tb % 44;
    f32x16 acc[2][2]; ACC_ZERO(acc)
    gemm_pf2(acc, h + (size_t)mt * 128 * 1024, 1024, w13 + (size_t)nt * 128 * 1024, 1024, 1024, nullptr);
#pragma unroll
    for (int i_ = 0; i_ < 2; ++i_)
#pragma unroll
      for (int r_ = 0; r_ < 16; ++r_) {
        const int row = wm * 64 + i_ * 32 + (r_ & 3) + 8 * (r_ >> 2) + 4 * (lane >> 5);
        const float gv = acc[i_][0][r_], uv = acc[i_][1][r_];
        hid[(size_t)(mt * 128 + row) * 2816 + nt * 64 + wn * 32 + (lane & 31)] = f2bf(silu_f(gv) * uv);
      }
  }
}
#define EPI4_LOOP_SB                                    \
  _Pragma("unroll") for (int i_ = 0; i_ < 4; ++i_)      \
  _Pragma("unroll") for (int j_ = 0; j_ < 2; ++j_)      \
  _Pragma("unroll") for (int r_ = 0; r_ < 16; ++r_)     \
    if ((r_ & 7) == 0 ? (__builtin_amdgcn_sched_barrier(0), true) : true)
__device__ __forceinline__ void ffn2_phase(const Params& p, const bf16_t* hid, const bf16_t* w2, int layer, bool latonly, int bid, int G) {
  WAVE_IDS
  const float* mod = (const float*)(p.ws + OFF_MOD) + (size_t)layer * 9 * 6144;
  for (int t = bid; t < 64 * 8; t += G) {
    const int lm = t >> 3, nt = t & 7, b = lm >> 3;
    const size_t hrow = latonly ? (size_t)lm * 256 : (size_t)b * TB + 256 + (size_t)(lm & 7) * 256;
    f32x16 acc[4][2]; ACC4_ZERO(acc)
    gemm_m256(acc, hid + hrow * 2816, 2816, w2 + (size_t)nt * 128 * 2816, 2816, 2816);
    const float* gate = mod + (size_t)b * 6144 + 5 * 1024;
    float* xo = p.out + (size_t)lm * 256 * 1024;
#pragma unroll
    for (int hh = 0; hh < 2; ++hh) {
      {
        float* sfw = (float*)g_sm;
#pragma unroll
        for (int ii = 0; ii < 2; ++ii)
#pragma unroll
          for (int j_ = 0; j_ < 2; ++j_)
#pragma unroll
            for (int r_ = 0; r_ < 16; ++r_)
              sfw[(wm * 64 + ii * 32 + (r_ & 3) + 8 * (r_ >> 2) + 4 * (lane >> 5)) * STASH_LD + EPI_COL] = acc[hh * 2 + ii][j_][r_];
      }
      __syncthreads();
      const float* sfr = (const float*)g_sm;
#pragma unroll 4
      for (int e = tid; e < 4096; e += 256) {
        const int sr = e >> 5, c0 = (e & 31) * 4;
        const int row = (sr >> 6) * 128 + hh * 64 + (sr & 63);
        const float4 a = *(const float4*)(sfr + sr * STASH_LD + c0);
        const float4 gg = *(const float4*)(gate + nt * 128 + c0);
        float4* dst = (float4*)(xo + (size_t)row * 1024 + nt * 128 + c0);
        float4 o = *dst;
        o.x += gg.x * a.x; o.y += gg.y * a.y; o.z += gg.z * a.z; o.w += gg.w * a.w;
        *dst = o;
      }
      __syncthreads();
    }
  }
  if (!latonly) {
    for (int t = G - 1 - bid; t < 16 * 8; t += G) {
      const int ci = t >> 3, nt = t & 7, mt = (ci >> 1) * 18 + (ci & 1);
      f32x16 acc[2][2]; ACC_ZERO(acc)
      gemm_pf2(acc, hid + (size_t)mt * 128 * 2816, 2816, w2 + (size_t)nt * 128 * 2816, 2816, 2816, nullptr);
      const float* gate = mod + (size_t)8 * 6144 + 5 * 1024;
      float* xo = xs_tile(p, mt);
      EPI_LOOP {
        const int row = EPI_ROW, col = nt * 128 + EPI_COL;
        xo[(size_t)row * 1024 + col] += gate[col] * acc[i_][j_][r_];
      }
    }
  }
}

__device__ __forceinline__ void ret_in_phase(const Params& p, int bid, int G) {
  WAVE_IDS
  const bf16_t* h = (const bf16_t*)(p.ws + L1_H);
  const bf16_t* wt = (const bf16_t*)(p.ws + L1_WIN);
  bf16_t* q = (bf16_t*)(p.ws + L1_Q);
  bf16_t* k = (bf16_t*)(p.ws + L1_K);
  bf16_t* kT = (bf16_t*)(p.ws + L1_KT);
  bf16_t* vT = (bf16_t*)(p.ws + L1_VT);
  const float* rc = (const float*)(p.ws + OFF_ROPE);
  const float* rs = rc + 2048 * 128;
  for (int t = bid; t < 4480; t += G) {
    int b, cc, nt;
    if (t < 4096) { const int li = t >> 5; b = li >> 4; cc = 2 + (li & 15); nt = t & 31; }
    else { const int t2 = t - 4096, ci = t2 / 24; b = ci >> 1; cc = ci & 1; nt = 8 + t2 % 24; }
    const int mt = b * 18 + cc, tt0 = cc * 128;
    f32x16 acc[2][2]; ACC_ZERO(acc)
    gemm_seg(acc, h + (size_t)mt * 128 * 1024, 1024, wt + (size_t)nt * 128 * 1024, 1024, 1024, nullptr);
    if (nt < 16) {
      if (cc >= 2) {
        const int pi = ((nt & 1) * 2 + wn) * 32 + (lane & 31);
#pragma unroll
        for (int i_ = 0; i_ < 2; ++i_)
#pragma unroll
          for (int r_ = 0; r_ < 16; ++r_) {
            const int row = wm * 64 + i_ * 32 + (r_ & 3) + 8 * (r_ >> 2) + 4 * (lane >> 5);
            const int pos = tt0 - 256 + row;
            const float c = rc[pos * 128 + pi], s = rs[pos * 128 + pi];
            const float t1 = acc[i_][0][r_], t2 = acc[i_][1][r_];
            acc[i_][0][r_] = t1 * c - t2 * s;
            acc[i_][1][r_] = t2 * c + t1 * s;
          }
      }
      if (cc >= 2) {
        bf16_t* dst = (nt < 8 ? q : k) + (size_t)(b * 2048 + tt0 - 256) * 1024 + (nt & 7) * 128;
        EPI_LOOP { dst[(size_t)EPI_ROW * 1024 + EPI_COL] = f2bf(acc[i_][j_][r_]); }
      }
    }
    if (nt >= 8) {
      bf16_t* dT;
      if (nt < 16) { const int kc = (nt - 8) * 128; dT = kT + ((size_t)(b * 4 + (kc >> 8)) * 256 + (kc & 255)) * TB; }
      else { const int vc = (nt - 16) * 128; dT = vT + ((size_t)(b * 4 + (vc >> 9)) * 512 + (vc & 511)) * TB; }
      {
        float* sfw = (float*)g_sm;
        EPI_LOOP { sfw[EPI_ROW * 129 + EPI_COL] = acc[i_][j_][r_]; }
        __syncthreads();
#pragma unroll 2
        for (int it = 0; it < 8; ++it) {
          const int e = it * 256 + tid, r8 = e & 15, col = e >> 4;
          const float* sp = sfw + (r8 * 8) * 129 + col;
          uint4 o;
          o.x = pack2(sp[0], sp[129]); o.y = pack2(sp[258], sp[387]); o.z = pack2(sp[516], sp[645]); o.w = pack2(sp[774], sp[903]);
          *(uint4*)(dT + (size_t)col * TB + tt0 + r8 * 8) = o;
        }
        __syncthreads();
      }
    }
  }
}

__device__ __forceinline__ void ret_headnorm_phase(const Params& p, int gw, int nw) {
  const int lane = threadIdx.x & 63;
  bf16_t* o = (bf16_t*)(p.ws + L1_O);
  const float* ng = p.in[30];
  for (int it = gw; it < 16384 * 4; it += nw) {
    const int R = it >> 2, hd = it & 3;
    bf16_t* ptr = o + (size_t)R * 2048 + hd * 512 + lane * 8;
    const uint4 v = *(const uint4*)ptr;
    float x[8] = {blo(v.x), bhi(v.x), blo(v.y), bhi(v.y), blo(v.z), bhi(v.z), blo(v.w), bhi(v.w)};
    float s = 0.f;
#pragma unroll
    for (int e = 0; e < 8; ++e) s += x[e];
    const float mu = wave_sum(s) * (1.f / 512.f);
    float q = 0.f;
#pragma unroll
    for (int e = 0; e < 8; ++e) { x[e] -= mu; q += x[e] * x[e]; }
    const float rs = rsqrtf(wave_sum(q) * (1.f / 512.f) + 1e-6f);
    const float* gg = ng + hd * 512 + lane * 8;
    uint4 w;
    w.x = pack2(x[0] * rs * gg[0], x[1] * rs * gg[1]); w.y = pack2(x[2] * rs * gg[2], x[3] * rs * gg[3]);
    w.z = pack2(x[4] * rs * gg[4], x[5] * rs * gg[5]); w.w = pack2(x[6] * rs * gg[6], x[7] * rs * gg[7]);
    *(uint4*)ptr = w;
  }
}

__device__ __forceinline__ void ret_gate_phase(const Params& p, int bid, int G) {
  WAVE_IDS
  const bf16_t* h = (const bf16_t*)(p.ws + L1_HL);
  const bf16_t* wt = (const bf16_t*)(p.ws + L1_WG);
  bf16_t* o = (bf16_t*)(p.ws + L1_O);
  for (int t = bid; t < 64 * 16; t += G) {
    const int mt = t >> 4, nt = t & 15;
    f32x16 acc[4][2]; ACC4_ZERO(acc)
    gemm_m256(acc, h + (size_t)mt * 256 * 1024, 1024, wt + (size_t)nt * 128 * 1024, 1024, 1024);
    EPI4_LOOP {
      bf16_t* dst = o + (size_t)(mt * 256 + EPI4_ROW) * 2048 + nt * 128 + EPI_COL;
      *dst = f2bf(silu_f(acc[i_][j_][r_]) * bf2f(*dst));
    }
  }
}

__device__ __forceinline__ void ret_wout_phase(const Params& p, int bid, int G) {
  WAVE_IDS
  const bf16_t* o = (const bf16_t*)(p.ws + L1_O);
  const bf16_t* wt = (const bf16_t*)(p.ws + L1_WOUT);
  const float* mod = (const float*)(p.ws + OFF_MOD) + (size_t)9 * 6144;
  for (int t = bid; t < 128 * 8; t += G) {
    const int mt = t >> 3, nt = t & 7;
    f32x16 acc[2][2]; ACC_ZERO(acc)
    gemm_pf2(acc, o + (size_t)mt * 128 * 2048, 2048, wt + (size_t)nt * 128 * 2048, 2048, 2048, nullptr);
    const float* gate = mod + (size_t)(mt >> 4) * 6144 + 2 * 1024;
    float* xo = p.out + (size_t)mt * 128 * 1024;
    EPI_LOOP {
      const int row = EPI_ROW, col = nt * 128 + EPI_COL;
      xo[(size_t)row * 1024 + col] += gate[col] * acc[i_][j_][r_];
    }
  }
}

__device__ __forceinline__ void final_norm_phase(const Params& p, int gw, int nw) {
  const int lane = threadIdx.x & 63;
  const float* g = p.in[34];
  for (int r = gw; r < 16384; r += nw) {
    float* src = p.out + (size_t)r * 1024;
    float4 xv[4]; float ss = 0.f;
#pragma unroll
    for (int j = 0; j < 4; ++j) {
      xv[j] = *(const float4*)(src + j * 256 + lane * 4);
      ss += xv[j].x * xv[j].x + xv[j].y * xv[j].y + xv[j].z * xv[j].z + xv[j].w * xv[j].w;
    }
    ss = wave_sum(ss);
    const float rstd = rsqrtf(ss * (1.f / 1024.f) + 1e-6f);
#pragma unroll
    for (int j = 0; j < 4; ++j) {
      const int c0 = j * 256 + lane * 4;
      const float4 gg = *(const float4*)(g + c0);
      float4 o; o.x = xv[j].x * rstd * gg.x; o.y = xv[j].y * rstd * gg.y; o.z = xv[j].z * rstd * gg.z; o.w = xv[j].w * rstd * gg.w;
      *(float4*)(src + c0) = o;
    }
  }
}

#define XB_TMO      128
#define XB_XCNT(j)  (256  + 64 * (j))
#define XB_XSUB(j)  (1280 + 64 * (j))
#define XB_XGEN(j)  (2304 + 64 * (j))
#define XB_TOP      3328
#define XB_TOPGEN   3392
#define XCD_BAR_WORDS 3456
#define XB_SPIN_CAP (1u << 18)
#define LAS __attribute__((address_space(3)))

__device__ __forceinline__ unsigned xb_ld(unsigned* p)              { return __hip_atomic_load(p, __ATOMIC_RELAXED, __HIP_MEMORY_SCOPE_AGENT); }
__device__ __forceinline__ unsigned xb_add(unsigned* p, unsigned v) { return __hip_atomic_fetch_add(p, v, __ATOMIC_RELAXED, __HIP_MEMORY_SCOPE_AGENT); }
__device__ __forceinline__ unsigned xb_xcc_id() { return (unsigned)__builtin_amdgcn_s_getreg((3 << 11) | 20) & 0xFu; }
#define XB_SPIN(cond, bar) do { unsigned _sp = 0; while (cond) { __builtin_amdgcn_s_sleep(4); \
    if ((++_sp & 255u) == 0u) { if (xb_ld(&(bar)[XB_TMO])) break; if (_sp > XB_SPIN_CAP) { atomicAdd(&(bar)[XB_TMO], 1u); break; } } } } while (0)

struct XcdBarrier {
    unsigned* bar; unsigned x;
    volatile LAS unsigned* st;
};

__device__ __forceinline__ XcdBarrier xcd_barrier_post(unsigned* bar, volatile LAS unsigned* st) {
    XcdBarrier b; b.bar = bar; b.x = xb_xcc_id(); b.st = st;
    if (threadIdx.x == 0) (void)xb_add(&bar[XB_XCNT(b.x)], 1u);
    return b;
}
__device__ __forceinline__ void xcd_barrier_complete(unsigned* bar, unsigned x, unsigned& nloc, unsigned& nx) {
    const unsigned G = gridDim.x * gridDim.y * gridDim.z;
    unsigned sum, cnt, mine, sp = 0u;
    for (;;) {
        sum = 0u; cnt = 0u; mine = 0u;
#pragma unroll
        for (unsigned j = 0; j < 16; ++j) { const unsigned c = xb_ld(&bar[XB_XCNT(j)]); sum += c; cnt += (c > 0u) ? 1u : 0u; mine = (j == x) ? c : mine; }
        if (sum == G) break;
        __builtin_amdgcn_s_sleep(1);
        if ((++sp & 255u) == 0u) { if (xb_ld(&bar[XB_TMO])) break; if (sp > XB_SPIN_CAP) { atomicAdd(&bar[XB_TMO], 1u); break; } }
    }
    nloc = mine > 0u ? mine : 1u; nx = cnt > 0u ? cnt : 1u;
}

__device__ __forceinline__ void xcd_barrier(const XcdBarrier& b) {
    asm volatile("s_waitcnt vmcnt(0)" ::: "memory");
    __syncthreads();
    if (threadIdx.x == 0) {
        unsigned* bar = b.bar;
        __builtin_amdgcn_s_waitcnt(0);
        unsigned nloc = b.st[0], nx = b.st[1];
        if (nloc == 0u) { xcd_barrier_complete(bar, b.x, nloc, nx); b.st[0] = nloc; b.st[1] = nx; }
        const unsigned old = xb_add(&bar[XB_XSUB(b.x)], 1u);
        const unsigned gen = old / nloc;
        if (old + 1u == (gen + 1u) * nloc) {
            __builtin_amdgcn_fence(__ATOMIC_RELEASE, "agent");
            asm volatile("s_waitcnt vmcnt(0)" ::: "memory");
            const unsigned og = xb_add(&bar[XB_TOP], 1u);
            const unsigned tg = og / nx;
            if (og + 1u == (tg + 1u) * nx) xb_add(&bar[XB_TOPGEN], 1u);
            else XB_SPIN(xb_ld(&bar[XB_TOPGEN]) == tg, bar);
            __builtin_amdgcn_fence(__ATOMIC_ACQUIRE, "agent");
            xb_add(&bar[XB_XGEN(b.x)], 1u);
            asm volatile("s_waitcnt vmcnt(0)" ::: "memory");
        } else {
            XB_SPIN(xb_ld(&bar[XB_XGEN(b.x)]) == gen, bar);
            __builtin_amdgcn_fence(__ATOMIC_ACQUIRE, "agent");
            asm volatile("s_waitcnt vmcnt(0)" ::: "memory");
        }
    }
    __syncthreads();
}


constexpr size_t OFF_BAR = 448 * 1024;
__shared__ uint4 g_xb;
__global__ void __launch_bounds__(256, 2) fwd_megakernel(Params p) {
  cg::grid_group grid = cg::this_grid();
  const int bid = blockIdx.x, G = gridDim.x;
  const int ngt = G * 256, nw = G * 4;
#define gt (bid * 256 + opaque_tid())
#define gw (bid * 4 + (opaque_tid() >> 6))
  unsigned char* ws = p.ws;
  unsigned* bar = (unsigned*)(ws + OFF_BAR);
  if (threadIdx.x == 0) g_xb = make_uint4(0u, 0u, 0u, 0u);
  __syncthreads();
  if (p.ws == nullptr) grid.sync();
  const XcdBarrier xb = xcd_barrier_post(bar, (volatile LAS unsigned*)&g_xb);

  ada_phase(p, bid, G);
  convert_w(p.in[8], nullptr, 1552, 1024, (bf16_t*)(ws + W0_IN), 52, 0, 1552, bid, G);
  convert_w(p.in[9], nullptr, 1024, 1024, (bf16_t*)(ws + W0_OUT), 32, 0, 1024, bid, G);
  convert_w(p.in[18], nullptr, 512, 512, (bf16_t*)(ws + W0_GLU), 16, 0, 512, bid, G);
  for (int hd = 0; hd < 4; ++hd) {
    if (G == 512) {
      const int o = 416 + 12 * hd;
      if (bid >= o && bid < o + 4) convert_w(p.in[22] + hd * 16384, nullptr, 128, 128, (bf16_t*)(ws + W0_Q) + hd * 16384, 4, 0, 128, bid - o, G);
      if (bid >= o + 4 && bid < o + 8) convert_w(p.in[23] + hd * 16384, nullptr, 128, 128, (bf16_t*)(ws + W0_K) + hd * 16384, 4, 3, 128, bid - o - 4, G);
      if (bid >= o + 8 && bid < o + 12) convert_w(p.in[24] + hd * 16384, nullptr, 128, 128, (bf16_t*)(ws + W0_V) + hd * 16384, 4, 0, 128, bid - o - 8, G);
    } else {
      convert_w(p.in[22] + hd * 16384, nullptr, 128, 128, (bf16_t*)(ws + W0_Q) + hd * 16384, 4, 0, 128, bid, G);
      convert_w(p.in[23] + hd * 16384, nullptr, 128, 128, (bf16_t*)(ws + W0_K) + hd * 16384, 4, 3, 128, bid, G);
      convert_w(p.in[24] + hd * 16384, nullptr, 128, 128, (bf16_t*)(ws + W0_V) + hd * 16384, 4, 0, 128, bid, G);
    }
  }
  convert_w(p.in[31], p.in[32], 2816, 1024, (bf16_t*)(ws + W0_13), 176, 1, 2816, bid, G);
  convert_w(p.in[33], nullptr, 1024, 2816, (bf16_t*)(ws + W0_2), 32, 0, 1024, bid, G);
  rope_phase(p, gt, ngt);
  if (G == 512) { if (bid >= 384) s5_ktab_phase(p, bid - 384, 128); }
  else s5_ktab_phase(p, G - 1 - bid, G);
  xcd_barrier(xb);
  rmsnorm_mod_phase(p, 0, p.in[6], 0, 0, (bf16_t*)(ws + OFF_H), gw, nw);
  s5_build_phase(p, gt, ngt);
  xcd_barrier(xb);
  l0_win_phase(p, bid, G);
  xcd_barrier(xb);
  s5_x_phase(p, bid, G);
  ml_conv_phase(p, gt, ngt);
  ml_gate_phase(p, gw, nw);
  xcd_barrier(xb);
  s5_scan_phase(p, gt, ngt);
  ml_prefix_phase(p, G - 1 - bid, G);
  ml_qkv_phase(p, bid, G);
  xcd_barrier(xb);
  ml_units_phase(p, bid, G);
  if (G == 512) { if (bid >= 128) s5_y_phase(p, bid - 128, 384); } else s5_y_phase(p, G - 1 - bid, G);
  xcd_barrier(xb);
  glu_phase(p, bid, G);
  ml_finish_phase(p, gw, nw);
  xcd_barrier(xb);
  l0_wout_phase(p, bid, G);
  xcd_barrier(xb);
  rmsnorm_mod_phase(p, 1, p.in[7], 0, 3, (bf16_t*)(ws + OFF_H), gw, nw);
  xcd_barrier(xb);
  ffn1_phase(p, (const bf16_t*)(ws + OFF_H), (const bf16_t*)(ws + W0_13), (bf16_t*)(ws + OFF_HID0), 144, bid, G);
  xcd_barrier(xb);
  ffn2_phase(p, (const bf16_t*)(ws + OFF_HID0), (const bf16_t*)(ws + W0_2), 0, false, bid, G);
  xcd_barrier(xb);
  rmsnorm_mod_phase(p, 1, p.in[6] + 1024, 1, 0, (bf16_t*)(ws + L1_H), gw, nw);
  convert_w(p.in[27], nullptr, 6144, 1024, (bf16_t*)(ws + L1_WIN), 192, 2, 6144, bid, G);
  xcd_barrier(xb);
  ret_in_phase(p, bid, G);
  xcd_barrier(xb);
  ret_scores_phase(p, bid, G);
  for (size_t e = gt; e < (size_t)16384 * 2048 * 2 / 16; e += ngt) ((uint4*)(ws + L1_O))[e] = make_uint4(0, 0, 0, 0);
  xcd_barrier(xb);
  if (bid >= G - 256) ret_chain_item(p, bid - (G - 256));
  xcd_barrier(xb);
  ret_headnorm_phase(p, gw, nw);
  rmsnorm_mod_phase(p, 2, p.in[6] + 1024, 1, 0, (bf16_t*)(ws + L1_HL), gw, nw);
  convert_w(p.in[27] + 4096, nullptr, 6144, 1024, (bf16_t*)(ws + L1_WG), 64, 0, 2048, bid, G);
  convert_w(p.in[28], nullptr, 1024, 2048, (bf16_t*)(ws + L1_WOUT), 32, 0, 1024, bid, G);
  convert_w(p.in[31] + (size_t)1024 * 2816, p.in[32] + (size_t)1024 * 2816, 2816, 1024, (bf16_t*)(ws + L1_W13), 176, 1, 2816, bid, G);
  convert_w(p.in[33] + (size_t)2816 * 1024, nullptr, 1024, 2816, (bf16_t*)(ws + L1_W2), 32, 0, 1024, bid, G);
  xcd_barrier(xb);
  ret_gate_phase(p, bid, G);
  xcd_barrier(xb);
  ret_wout_phase(p, bid, G);
  xcd_barrier(xb);
  rmsnorm_mod_phase(p, 2, p.in[7] + 1024, 1, 3, (bf16_t*)(ws + L1_H2), gw, nw);
  xcd_barrier(xb);
  ffn1_phase(p, (const bf16_t*)(ws + L1_H2), (const bf16_t*)(ws + L1_W13), (bf16_t*)(ws + L1_HID), 128, bid, G);
  xcd_barrier(xb);
  ffn2_phase(p, (const bf16_t*)(ws + L1_HID), (const bf16_t*)(ws + L1_W2), 1, true, bid, G);
  xcd_barrier(xb);
  final_norm_phase(p, gw, nw);
}

#undef gt
#undef gw
extern "C" void kernel_launch(void* const* d_in, const int* in_sizes, int n_in, void* d_out, int out_size,
                              void* d_ws, size_t ws_size, hipStream_t stream) {
  static int grid_blocks = 0;
  if (!grid_blocks) {
    int dev = 0, cus = 0, per_cu = 0;
    (void)hipGetDevice(&dev);
    (void)hipDeviceGetAttribute(&cus, hipDeviceAttributeMultiprocessorCount, dev);
    (void)hipOccupancyMaxActiveBlocksPerMultiprocessor(&per_cu, fwd_megakernel, 256, 0);
    if (per_cu > 2) per_cu = 2;
    if (per_cu < 1) per_cu = 1;
    grid_blocks = cus * per_cu;
  }
  Params p{};
  for (int i = 0; i < 35; ++i) p.in[i] = (const float*)d_in[i];
  p.out = (float*)d_out;
  p.ws = (unsigned char*)d_ws;
  (void)hipMemsetAsync((unsigned char*)d_ws + OFF_BAR, 0, XCD_BAR_WORDS * sizeof(unsigned), stream);
  void* args[] = {&p};
  hipError_t e = hipLaunchCooperativeKernel((void*)fwd_megakernel, dim3(grid_blocks), dim3(256), args, 0, stream);
  if (e != hipSuccess) fprintf(stderr, "cooperative launch failed: %s (grid %d)\n", hipGetErrorString(e), grid_blocks);
}
```
